# Optimizing an MI355X kernel written in HIP

```python
import math
import jax
import jax.numpy as jnp
from jax import lax
import numpy as np

D_MODEL = 1024
BATCH = 16
SEQ = 2048
DEPTH = 2

GRID_W = 64
CTX_LEN = 256
N_MIXERS = 2
NORM_EPS = 1e-6
S5_GROUP = 16
S5_GROUPS = D_MODEL // S5_GROUP
S5_STATE = 64
S5_CHUNK = 128
S5_DT_MIN = 1e-3
S5_DT_MAX = 1e-1
DA_HEAD_DIM = 64
DA_VDIM = 2 * DA_HEAD_DIM
DA_HEADS = D_MODEL // DA_VDIM
Q_BLOCK = 128
ROPE_BASE = 10000.0
N_EXPERTS = 32
TOP_K = 4
D_FF = D_MODEL
SWIGLU_LIMIT = 7.0
SWIGLU_ALPHA = 1.702
MOE_BLOCK = 128

kernel_name = 'hybrid_s5_diffattn_moe_dit'


def rmsnorm(x, g):
    xf = x.astype(jnp.float32)
    y = xf * lax.rsqrt(jnp.mean(xf * xf, axis=-1, keepdims=True) + NORM_EPS)
    return (y * g.astype(jnp.float32)).astype(x.dtype)


def axial_rope(n_tokens, dim):
    rows = n_tokens // GRID_W
    row = jnp.repeat(jnp.arange(rows, dtype=jnp.float32), GRID_W)
    col = jnp.tile(jnp.arange(GRID_W, dtype=jnp.float32), rows)
    n_freq = dim // 4
    inv_freq = jnp.exp(-math.log(ROPE_BASE) * jnp.arange(n_freq, dtype=jnp.float32) / n_freq)
    ang = jnp.concatenate([row[:, None] * inv_freq, col[:, None] * inv_freq], axis=-1)
    return jnp.cos(ang), jnp.sin(ang)


def apply_rope(x, cos, sin):
    half = x.shape[-1] // 2
    x1, x2 = x[..., :half], x[..., half:]
    out = jnp.concatenate([x1 * cos - x2 * sin, x2 * cos + x1 * sin], axis=-1)
    return out.astype(x.dtype)


def s5_discretise(a_re, a_im, log_dt, b_re, b_im):
    a = lax.complex(a_re.astype(jnp.float32), a_im.astype(jnp.float32))
    dt = jnp.exp(log_dt.astype(jnp.float32))[:, None]
    log_lam = a * dt
    b = lax.complex(b_re.astype(jnp.float32), b_im.astype(jnp.float32))
    b_bar = ((jnp.exp(log_lam) - 1.0) / a)[..., None] * b
    return log_lam, b_bar


def _linear_combine(left, right):
    a1, b1 = left
    a2, b2 = right
    return a1 * a2, a2 * b1 + b2


def s5_scan(u, log_lam, b_bar, c_mat, h0):
    bsz, n = u.shape[0], u.shape[1]
    n_chunks = n // S5_CHUNK
    u_chunks = jnp.moveaxis(u.reshape((bsz, n_chunks, S5_CHUNK) + u.shape[2:]), 1, 0)
    lam = jnp.exp(log_lam)
    steps = jnp.arange(1, S5_CHUNK + 1, dtype=jnp.float32)[:, None, None]
    lam_pow = jnp.exp(log_lam[None] * steps)

    def step(h, u_c):
        bu = jnp.einsum('btgc,gpc->btgp', u_c.astype(jnp.complex64), b_bar)
        lam_b = jnp.broadcast_to(lam, bu.shape)
        _, hs = lax.associative_scan(_linear_combine, (lam_b, bu), axis=1)
        hs = hs + lam_pow[None] * h[:, None]
        y = jnp.einsum('btgp,gcp->btgc', hs, c_mat).real
        return hs[:, -1], y

    h_fin, ys = lax.scan(step, h0, u_chunks)
    return jnp.moveaxis(ys, 0, 1).reshape(u.shape), h_fin


def s5_mixer(h_lat, h_ctx, a_re, a_im, log_dt, b_re, b_im, c_re, c_im, d_skip, w_glu, b_glu, need_ctx):
    def grouped(h):
        return h.astype(jnp.float32).reshape(h.shape[:2] + (S5_GROUPS, S5_GROUP))
    u_l, u_c = grouped(h_lat), grouped(h_ctx)
    y_l = jnp.zeros_like(u_l)
    y_c = jnp.zeros_like(u_c)
    for d in range(2):
        log_lam, b_bar = s5_discretise(a_re[d], a_im[d], log_dt[d], b_re[d], b_im[d])
        c_mat = lax.complex(c_re[d].astype(jnp.float32), c_im[d].astype(jnp.float32))
        orient = (lambda t: jnp.flip(t, axis=1)) if d == 1 else (lambda t: t)
        h0 = jnp.zeros((u_c.shape[0], S5_GROUPS, S5_STATE), jnp.complex64)
        yc, h_ctx_fin = s5_scan(orient(u_c), log_lam, b_bar, c_mat, h0)
        yl, _ = s5_scan(orient(u_l), log_lam, b_bar, c_mat, h_ctx_fin)
        y_l = y_l + orient(yl)
        y_c = y_c + orient(yc)
    d_g = d_skip.astype(jnp.float32).reshape(S5_GROUPS, S5_GROUP)

    def finish(y, u, dtype):
        y = (y + d_g * u).reshape(y.shape[:2] + (D_MODEL,))
        y = jax.nn.gelu(y).astype(dtype)
        a, g = jnp.split(y @ w_glu + b_glu, 2, axis=-1)
        return a * jax.nn.sigmoid(g)

    out_l = finish(y_l, u_l, h_lat.dtype)
    out_c = finish(y_c, u_c, h_ctx.dtype) if need_ctx else None
    return out_l, out_c


def diff_core(q, k, v, lam):
    s = jnp.einsum('bqhcd,bkhcd->bhcqk', q, k).astype(jnp.float32) * (DA_HEAD_DIM ** -0.5)
    p = jax.nn.softmax(s, axis=-1)
    a = p[:, :, 0] - lam * p[:, :, 1]
    return jnp.einsum('bhqk,bkhe->bqhe', a.astype(v.dtype), v)


def diff_attention(h_lat, h_ctx, w_qkv, w_o, q_gain, k_gain, lam_q1, lam_k1, lam_q2, lam_k2,
                   sub_gain, lambda_init, need_ctx):
    bsz, n_lat = h_lat.shape[0], h_lat.shape[1]

    def project(h):
        q, k, v = jnp.split(h @ w_qkv, 3, axis=-1)
        shp = h.shape[:2] + (DA_HEADS, 2, DA_HEAD_DIM)
        q = rmsnorm(q.reshape(shp), q_gain)
        k = rmsnorm(k.reshape(shp), k_gain)
        v = v.reshape(h.shape[:2] + (DA_HEADS, DA_VDIM))
        return q, k, v

    q_l, k_l, v_l = project(h_lat)
    cos, sin = axial_rope(n_lat, DA_HEAD_DIM)
    cos = cos[:, None, None, :]
    sin = sin[:, None, None, :]
    q_l = apply_rope(q_l, cos, sin)
    k_l = apply_rope(k_l, cos, sin)
    q_c, k_c, v_c = project(h_ctx)
    k_all = jnp.concatenate([k_c, k_l], axis=1)
    v_all = jnp.concatenate([v_c, v_l], axis=1)
    lam = (jnp.exp(jnp.sum(lam_q1.astype(jnp.float32) * lam_k1.astype(jnp.float32)))
           - jnp.exp(jnp.sum(lam_q2.astype(jnp.float32) * lam_k2.astype(jnp.float32)))
           + lambda_init)

    def finish(o):
        o = rmsnorm(o, sub_gain) * (1.0 - lambda_init)
        return o.reshape(o.shape[:2] + (D_MODEL,)) @ w_o

    n_blk = n_lat // Q_BLOCK
    q_blocks = jnp.moveaxis(q_l.reshape((bsz, n_blk, Q_BLOCK) + q_l.shape[2:]), 1, 0)
    o_blocks = lax.map(lambda qb: diff_core(qb, k_all, v_all, lam), q_blocks)
    o_l = jnp.moveaxis(o_blocks, 0, 1).reshape((bsz, n_lat, DA_HEADS, DA_VDIM))
    y_l = finish(o_l)
    y_c = finish(diff_core(q_c, k_c, v_c, lam)) if need_ctx else None
    return y_l, y_c


def moe_ffn(h, w_router, b_router, w_gu, b_gu, w_down, b_down):
    n_tok, d = h.shape
    logits = (h @ w_router).astype(jnp.float32) + b_router.astype(jnp.float32)
    top_logit, top_e = lax.top_k(logits, TOP_K)
    gates = jax.nn.softmax(top_logit, axis=-1)
    nk = n_tok * TOP_K
    flat_e = top_e.reshape(nk)
    flat_tok = jnp.arange(nk, dtype=jnp.int32) // TOP_K
    flat_gate = gates.reshape(nk)
    order = jnp.argsort(flat_e, stable=True)
    sorted_e = flat_e[order]
    counts = jnp.bincount(flat_e, length=N_EXPERTS)
    padded = (counts + MOE_BLOCK - 1) // MOE_BLOCK * MOE_BLOCK
    pad_end = jnp.cumsum(padded)
    pad_start = pad_end - padded
    start = jnp.cumsum(counts) - counts
    dest = pad_start[sorted_e] + jnp.arange(nk, dtype=jnp.int32) - start[sorted_e]
    n_blocks = -(-nk // MOE_BLOCK) + N_EXPERTS
    buf = n_blocks * MOE_BLOCK
    tok_buf = jnp.zeros((buf,), jnp.int32).at[dest].set(flat_tok[order])
    gate_buf = jnp.zeros((buf,), jnp.float32).at[dest].set(flat_gate[order])
    block_start = jnp.arange(n_blocks, dtype=jnp.int32) * MOE_BLOCK
    block_e = jnp.minimum(jnp.searchsorted(pad_end, block_start, side='right'), N_EXPERTS - 1)

    def expert_block(args):
        toks, e = args
        xb = h[toks]
        gu = xb @ w_gu[e] + b_gu[e]
        gate, up = jnp.split(gu, 2, axis=-1)
        gate = jnp.minimum(gate, SWIGLU_LIMIT)
        up = jnp.clip(up, -SWIGLU_LIMIT, SWIGLU_LIMIT)
        act = (up + 1.0) * gate * jax.nn.sigmoid(SWIGLU_ALPHA * gate)
        return act @ w_down[e] + b_down[e]

    y = lax.map(expert_block, (tok_buf.reshape(n_blocks, MOE_BLOCK), block_e))
    y = y.reshape(buf, d) * gate_buf[:, None].astype(y.dtype)
    return jnp.zeros_like(h).at[tok_buf].add(y)


def setup_inputs(seed: int = 0) -> dict:
    key = jax.random.key(seed)
    ks = iter(jax.random.split(key, 48))
    f32 = jnp.float32
    n_a = (DEPTH + N_MIXERS - 1) // N_MIXERS
    n_b = DEPTH // N_MIXERS
    G, P, CG = S5_GROUPS, S5_STATE, S5_GROUP

    def nrm(shape, std):
        return jax.random.normal(next(ks), shape, f32) * std

    x = nrm((BATCH, SEQ, D_MODEL), 1.0)
    c = nrm((BATCH, D_MODEL), 1.0)
    ctx = nrm((BATCH, CTX_LEN, D_MODEL), 1.0)
    c_ctx = nrm((D_MODEL,), 1.0)
    w_ada = nrm((DEPTH, D_MODEL, 6 * D_MODEL), 0.3 * D_MODEL ** -0.5)
    b_ada = nrm((DEPTH, 6 * D_MODEL), 0.02)
    g_mix = 1.0 + nrm((DEPTH, D_MODEL), 0.02)
    g_ffn = 1.0 + nrm((DEPTH, D_MODEL), 0.02)
    s5_a_re = -0.5 + nrm((n_a, 2, G, P), 0.01)
    s5_a_im = math.pi * jnp.arange(P, dtype=f32) + nrm((n_a, 2, G, P), 0.01)
    s5_log_dt = jax.random.uniform(next(ks), (n_a, 2, G), f32, math.log(S5_DT_MIN), math.log(S5_DT_MAX))
    s5_b_re = nrm((n_a, 2, G, P, CG), (2 * CG) ** -0.5)
    s5_b_im = nrm((n_a, 2, G, P, CG), (2 * CG) ** -0.5)
    s5_c_re = nrm((n_a, 2, G, CG, P), P ** -0.5)
    s5_c_im = nrm((n_a, 2, G, CG, P), P ** -0.5)
    s5_d = nrm((n_a, D_MODEL), 0.5)
    s5_w_glu = nrm((n_a, D_MODEL, 2 * D_MODEL), D_MODEL ** -0.5)
    s5_b_glu = nrm((n_a, 2 * D_MODEL), 0.02)
    da_w_qkv = nrm((n_b, D_MODEL, 3 * D_MODEL), D_MODEL ** -0.5)
    da_w_o = nrm((n_b, D_MODEL, D_MODEL), D_MODEL ** -0.5)
    da_q_gain = 1.0 + nrm((n_b, DA_HEAD_DIM), 0.02)
    da_k_gain = 1.0 + nrm((n_b, DA_HEAD_DIM), 0.02)
    da_lam_q1 = nrm((n_b, DA_HEAD_DIM), 0.1)
    da_lam_k1 = nrm((n_b, DA_HEAD_DIM), 0.1)
    da_lam_q2 = nrm((n_b, DA_HEAD_DIM), 0.1)
    da_lam_k2 = nrm((n_b, DA_HEAD_DIM), 0.1)
    da_sub_gain = 1.0 + nrm((n_b, DA_VDIM), 0.02)
    moe_w_router = nrm((DEPTH, D_MODEL, N_EXPERTS), D_MODEL ** -0.5)
    moe_b_router = nrm((DEPTH, N_EXPERTS), 0.01)
    moe_w_gu = nrm((DEPTH, N_EXPERTS, D_MODEL, 2 * D_FF), D_MODEL ** -0.5)
    moe_b_gu = nrm((DEPTH, N_EXPERTS, 2 * D_FF), 0.02)
    moe_w_down = nrm((DEPTH, N_EXPERTS, D_FF, D_MODEL), D_FF ** -0.5)
    moe_b_down = nrm((DEPTH, N_EXPERTS, D_MODEL), 0.02)
    return {'x': x, 'c': c, 'ctx': ctx, 'c_ctx': c_ctx,
            'w_ada': w_ada, 'b_ada': b_ada, 'g_mix': g_mix, 'g_ffn': g_ffn,
            's5_a_re': s5_a_re, 's5_a_im': s5_a_im, 's5_log_dt': s5_log_dt,
            's5_b_re': s5_b_re, 's5_b_im': s5_b_im, 's5_c_re': s5_c_re, 's5_c_im': s5_c_im,
            's5_d': s5_d, 's5_w_glu': s5_w_glu, 's5_b_glu': s5_b_glu,
            'da_w_qkv': da_w_qkv, 'da_w_o': da_w_o, 'da_q_gain': da_q_gain, 'da_k_gain': da_k_gain,
            'da_lam_q1': da_lam_q1, 'da_lam_k1': da_lam_k1, 'da_lam_q2': da_lam_q2, 'da_lam_k2': da_lam_k2,
            'da_sub_gain': da_sub_gain,
            'moe_w_router': moe_w_router, 'moe_b_router': moe_b_router, 'moe_w_gu': moe_w_gu,
            'moe_b_gu': moe_b_gu, 'moe_w_down': moe_w_down, 'moe_b_down': moe_b_down}


def reference(x, c, ctx, c_ctx, w_ada, b_ada, g_mix, g_ffn,
              s5_a_re, s5_a_im, s5_log_dt, s5_b_re, s5_b_im, s5_c_re, s5_c_im,
              s5_d, s5_w_glu, s5_b_glu,
              da_w_qkv, da_w_o, da_q_gain, da_k_gain, da_lam_q1, da_lam_k1, da_lam_q2, da_lam_k2,
              da_sub_gain,
              moe_w_router, moe_b_router, moe_w_gu, moe_b_gu, moe_w_down, moe_b_down):
    silu_c = jax.nn.silu(c)
    silu_cc = jax.nn.silu(c_ctx)
    for i in range(DEPTH):
        last = i == DEPTH - 1
        j = i // N_MIXERS
        mod_l = (silu_c @ w_ada[i] + b_ada[i])[:, None, :]
        mod_c = silu_cc @ w_ada[i] + b_ada[i]
        sh1, sc1, gt1, sh2, sc2, gt2 = jnp.split(mod_l, 6, axis=-1)
        csh1, csc1, cgt1, csh2, csc2, cgt2 = jnp.split(mod_c, 6, axis=-1)
        h_l = rmsnorm(x, g_mix[i]) * (1.0 + sc1) + sh1
        h_c = rmsnorm(ctx, g_mix[i]) * (1.0 + csc1) + csh1
        if i % N_MIXERS == 0:
            y_l, y_c = s5_mixer(h_l, h_c, s5_a_re[j], s5_a_im[j], s5_log_dt[j], s5_b_re[j], s5_b_im[j],
                                s5_c_re[j], s5_c_im[j], s5_d[j], s5_w_glu[j], s5_b_glu[j], not last)
        else:
            lambda_init = 0.8 - 0.6 * math.exp(-0.3 * i)
            y_l, y_c = diff_attention(h_l, h_c, da_w_qkv[j], da_w_o[j], da_q_gain[j], da_k_gain[j],
                                      da_lam_q1[j], da_lam_k1[j], da_lam_q2[j], da_lam_k2[j],
                                      da_sub_gain[j], lambda_init, not last)
        x = x + gt1 * y_l
        if not last:
            ctx = ctx + cgt1 * y_c
        h_l = rmsnorm(x, g_ffn[i]) * (1.0 + sc2) + sh2
        if last:
            out = moe_ffn(h_l.reshape(-1, D_MODEL), moe_w_router[i], moe_b_router[i], moe_w_gu[i],
                          moe_b_gu[i], moe_w_down[i], moe_b_down[i])
            x = x + gt2 * out.reshape(x.shape)
        else:
            h_c = rmsnorm(ctx, g_ffn[i]) * (1.0 + csc2) + csh2
            n_c = h_c.shape[0] * h_c.shape[1]
            tokens = jnp.concatenate([h_c.reshape(-1, D_MODEL), h_l.reshape(-1, D_MODEL)], axis=0)
            out = moe_ffn(tokens, moe_w_router[i], moe_b_router[i], moe_w_gu[i],
                          moe_b_gu[i], moe_w_down[i], moe_b_down[i])
            ctx = ctx + cgt2 * out[:n_c].reshape(ctx.shape)
            x = x + gt2 * out[n_c:].reshape(x.shape)
    return x
```

```cpp
#include <hip/hip_runtime.h>
#include <cstdio>
#include <cstdint>

#define LAS __attribute__((address_space(3)))
#define GAS __attribute__((address_space(1)))
typedef unsigned short bf16;
typedef short bf16x8 __attribute__((ext_vector_type(8)));
typedef short s16x4 __attribute__((ext_vector_type(4)));
typedef float f32x4 __attribute__((ext_vector_type(4)));
typedef float f32x2 __attribute__((ext_vector_type(2)));
typedef float f32x16 __attribute__((ext_vector_type(16)));
typedef unsigned u32x4 __attribute__((ext_vector_type(4)));
typedef unsigned u32x2 __attribute__((ext_vector_type(2)));
typedef LAS unsigned char* ldsp;
typedef int v8i __attribute__((ext_vector_type(8)));
typedef int v4i __attribute__((ext_vector_type(4)));

#ifndef MK_ONE_LAUNCH
#define MK_ONE_LAUNCH 1
#endif
#ifndef ATTN_SKEW
#define ATTN_SKEW 10
#endif
#ifndef SPLIT_A
#define SPLIT_A 20
#endif

constexpr int NB = 16, LSEQ = 2048, CTXL = 256, DM = 1024, SB = LSEQ + CTXL, NROW = NB * SB, NLAT = NB * LSEQ;
constexpr int NEXP = 32, TOPK = 4;
constexpr int NCHUNK = SB / 16;
constexpr int MAXTILES = NROW * TOPK / 256 + NEXP;
constexpr int ACT_ROWS = MAXTILES * 256;
constexpr int NPHASE = 17;
constexpr float NORM_EPS = 1e-6f;
constexpr float LAMBDA_INIT = 0.35550906759f;
constexpr float W8_SCALE = 32.0f, W8_INV = 1.0f / 32.0f;

constexpr size_t MiB = 1u << 20;
constexpr size_t WS_CTL = 0, CTL_ZERO_BYTES = 1 * MiB;
constexpr size_t WS_MOD = 1 * MiB;
constexpr size_t WS_LAMT = 2 * MiB;
constexpr size_t WS_ROUTE_E = 3 * MiB;
constexpr size_t WS_ROUTE_P = 4 * MiB;
constexpr size_t WS_ROUTE_G = 5 * MiB;
constexpr size_t WS_TOKL = 6 * MiB;
constexpr size_t WS_WGLU = 16 * MiB, WS_WQKV = 20 * MiB, WS_WO = 26 * MiB, WS_ACAT = 28 * MiB, WS_FMAT = 44 * MiB;
constexpr size_t WS_WGU = 64 * MiB;
constexpr size_t WS_WDN = 320 * MiB;
constexpr size_t WS_XS1 = 448 * MiB;
constexpr size_t WS_XS2 = 592 * MiB;
constexpr size_t WS_HB = 736 * MiB;
constexpr size_t WS_ACT = 808 * MiB;
constexpr size_t WS_YS = 1112 * MiB;
constexpr size_t WS_BCAT = 1416 * MiB;
constexpr size_t WS_SBUF = 1560 * MiB;
constexpr size_t WS_YG0 = WS_SBUF, WS_YG1 = WS_BCAT;
constexpr size_t WS_Q = WS_BCAT, WS_K = WS_BCAT + 64 * MiB, WS_VT = WS_SBUF, WS_OATT = WS_SBUF + 72 * MiB;
constexpr size_t WS_END = 1704 * MiB;
static_assert((size_t)ACT_ROWS * 2048 <= 304 * MiB, "act rows");
constexpr int CW_BAR = 4096;
constexpr int CW_BAR2 = 8192;
constexpr int CW_CNT = 16384;

constexpr int STAGE_BYTES = 131072;
constexpr int MISC_OFF = STAGE_BYTES + 1024;
constexpr int LDS_BYTES = MISC_OFF + 16384;
constexpr int MO_BAR = 0;
constexpr int MO_PREF = 64;
constexpr int MO_CNT = 256;
constexpr int MO_HIST = 512;
constexpr int MO_BASE = 768;
constexpr int MO_SEL = 1024;
constexpr int MO_VEC = 8192;
constexpr int MO_TOK = 12288;
constexpr int MO_GAIN = 15360;

#define LDS_WAIT() asm volatile("s_waitcnt lgkmcnt(0)" ::: "memory")
#define VM_WAIT() asm volatile("s_waitcnt vmcnt(0)" ::: "memory")
__device__ __forceinline__ unsigned f2bf(float f) { unsigned u = __builtin_bit_cast(unsigned, f); return (u + 0x7fffu + ((u >> 16) & 1u)) >> 16; }
__device__ __forceinline__ unsigned pk2(float lo, float hi) { return f2bf(lo) | (f2bf(hi) << 16); }
__device__ __forceinline__ unsigned cvt_pk_bf16(float lo, float hi) { unsigned r; asm volatile("v_cvt_pk_bf16_f32 %0, %1, %2" : "=v"(r) : "v"(lo), "v"(hi)); return r; }
typedef __bf16 bf2_t __attribute__((ext_vector_type(2)));
__device__ __forceinline__ unsigned pkbf(float lo, float hi) { f32x2 v = {lo, hi}; return __builtin_bit_cast(unsigned, __builtin_convertvector(v, bf2_t)); }
__device__ __forceinline__ float bf_lo(unsigned w) { return __builtin_bit_cast(float, w << 16); }
__device__ __forceinline__ float bf_hi(unsigned w) { return __builtin_bit_cast(float, w & 0xffff0000u); }
__device__ __forceinline__ float wave_sum(float v) {
#pragma unroll
    for (int o = 1; o < 64; o <<= 1) v += __shfl_xor(v, o);
    return v;
}
__device__ __forceinline__ float fast_sigmoid(float x) { return __builtin_amdgcn_rcpf(1.0f + __builtin_amdgcn_exp2f(-1.44269504089f * x)); }
__device__ __forceinline__ float silu_f(float x) { return x / (1.0f + __expf(-x)); }
__device__ __forceinline__ float gelu_tanh(float x) {
    const float t = 1.5957691216f * (x + 0.044715f * x * x * x);
    return x * fast_sigmoid(t);
}

#define XB_TMO      128
#define XB_XCNT(j)  (256  + 64 * (j))
#define XB_XSUB(j)  (1280 + 64 * (j))
#define XB_XGEN(j)  (2304 + 64 * (j))
#define XB_TOP      3328
#define XB_TOPGEN   3392
#define XCD_BAR_WORDS 3456
#define XB_SPIN_CAP (1u << 18)
__device__ __forceinline__ unsigned xb_ld(unsigned* p)              { return __hip_atomic_load(p, __ATOMIC_RELAXED, __HIP_MEMORY_SCOPE_AGENT); }
__device__ __forceinline__ unsigned xb_add(unsigned* p, unsigned v) { return __hip_atomic_fetch_add(p, v, __ATOMIC_RELAXED, __HIP_MEMORY_SCOPE_AGENT); }
__device__ __forceinline__ unsigned xb_xcc_id() { return (unsigned)__builtin_amdgcn_s_getreg((3 << 11) | 20) & 0xFu; }
#define XB_SPIN(cond, bar) do { unsigned _sp = 0; while (cond) { __builtin_amdgcn_s_sleep(1); \
    if ((++_sp & 255u) == 0u) { if (xb_ld(&(bar)[XB_TMO])) break; if (_sp > XB_SPIN_CAP) { atomicAdd(&(bar)[XB_TMO], 1u); break; } } } } while (0)
struct XcdBarrier { unsigned* bar; unsigned x; volatile LAS unsigned* st; unsigned total; };
__device__ __forceinline__ XcdBarrier xcd_barrier_post(unsigned* bar, volatile LAS unsigned* st, unsigned total) {
    XcdBarrier b; b.bar = bar; b.x = xb_xcc_id(); b.st = st; b.total = total;
    if (threadIdx.x == 0) (void)xb_add(&bar[XB_XCNT(b.x)], 1u);
    return b;
}
__device__ __forceinline__ void xcd_barrier_complete(unsigned* bar, unsigned x, unsigned G, unsigned& nloc, unsigned& nx) {
    unsigned sum, cnt, mine, sp = 0u;
    for (;;) {
        sum = 0u; cnt = 0u; mine = 0u;
#pragma unroll
        for (unsigned j = 0; j < 16; ++j) { const unsigned c = xb_ld(&bar[XB_XCNT(j)]); sum += c; cnt += (c > 0u) ? 1u : 0u; mine = (j == x) ? c : mine; }
        if (sum == G) break;
        __builtin_amdgcn_s_sleep(1);
        if ((++sp & 255u) == 0u) { if (xb_ld(&bar[XB_TMO])) break; if (sp > XB_SPIN_CAP) { atomicAdd(&bar[XB_TMO], 1u); break; } }
    }
    nloc = mine > 0u ? mine : 1u; nx = cnt > 0u ? cnt : 1u;
}
__device__ __forceinline__ void xcd_barrier(const XcdBarrier& b) {
    asm volatile("s_waitcnt vmcnt(0)" ::: "memory");
    __syncthreads();
    if (threadIdx.x == 0) {
        unsigned* bar = b.bar;
        __builtin_amdgcn_s_waitcnt(0);
        unsigned nloc = b.st[0], nx = b.st[1];
        if (nloc == 0u) { xcd_barrier_complete(bar, b.x, b.total, nloc, nx); b.st[0] = nloc; b.st[1] = nx; }
        const unsigned old = xb_add(&bar[XB_XSUB(b.x)], 1u);
        const unsigned gen = old / nloc;
        if (old + 1u == (gen + 1u) * nloc) {
            __builtin_amdgcn_fence(__ATOMIC_RELEASE, "agent");
            asm volatile("s_waitcnt vmcnt(0)" ::: "memory");
            const unsigned og = xb_add(&bar[XB_TOP], 1u);
            const unsigned tg = og / nx;
            if (og + 1u == (tg + 1u) * nx) xb_add(&bar[XB_TOPGEN], 1u);
            else XB_SPIN(xb_ld(&bar[XB_TOPGEN]) == tg, bar);
            __builtin_amdgcn_fence(__ATOMIC_ACQUIRE, "agent");
            xb_add(&bar[XB_XGEN(b.x)], 1u);
            asm volatile("s_waitcnt vmcnt(0)" ::: "memory");
        } else {
            XB_SPIN(xb_ld(&bar[XB_XGEN(b.x)]) == gen, bar);
            __builtin_amdgcn_fence(__ATOMIC_ACQUIRE, "agent");
            asm volatile("s_waitcnt vmcnt(0)" ::: "memory");
        }
    }
    __syncthreads();
}

namespace g8 {
constexpr int BM = 256, BK = 64, HALF = 128, HTB = HALF * BK * 2;
__host__ __device__ __forceinline__ int lds_byte(int r, int c) { const int st = (r >> 4) * 2 + (c >> 5), rr = r & 15, cc = c & 31, ob = rr * 64 + cc * 2; return st * 1024 + (ob ^ (((ob >> 9) & 1) << 5)); }
__host__ __device__ __forceinline__ void stage_rc(int b, int& R, int& C) { const int st = b / 1024, sb = b % 1024, swz = sb ^ (((sb >> 9) & 1) << 5); R = (st >> 1) * 16 + swz / 64; C = (st & 1) * 32 + (swz % 64) / 2; }
__host__ __device__ __forceinline__ int col_of_slot32(int s) { const int n = s >> 4, i = s & 15; return 8 * (i >> 2) + 4 * n + (i & 3); }
__host__ __device__ __forceinline__ int slot_of_col32(int c) { return 16 * ((c >> 2) & 1) + 4 * (c >> 3) + (c & 3); }

struct Unit { const char* A; const char* B; int pm, pn, e, cnt, tb; };

__device__ __forceinline__ bool static_order_l(long L, int nM, int nN, int& pm, int& pn) {
    const int nwg = nM * nN; if (L >= nwg) return false;
    int wgid = (int)L; { const int q = nwg / 8, r = nwg % 8, xcd = wgid % 8, off = wgid / 8; wgid = (xcd < r ? xcd * (q + 1) : r * (q + 1) + (xcd - r) * q) + off; }
    const int nig = 8 * nN, gid = wgid / nig, fm = gid * 8, gsz = (nM - fm) < 8 ? (nM - fm) : 8;
    pm = fm + ((wgid % nig) % gsz); pn = (wgid % nig) / gsz; return true;
}

__device__ __forceinline__ bool static_order(int i, int G, int c, int nM, int nN, int& pm, int& pn) { return static_order_l((long)i * G + c, nM, nN, pm, pn); }

template <class P, int PROBE = 0>
__device__ __forceinline__ void gemm_phase(ldsp lds, const P& p) {
    const int tid = threadIdx.x, wid = __builtin_amdgcn_readfirstlane(tid >> 6), lane = tid & 63, wr = wid >> 2, wc = wid & 3, fr = lane & 15, fq = lane >> 4;
    const int nt = (P::FP8 ? p.K : p.K * 2) / 128;
    const int ldbB = P::FP8 ? p.ldb : p.ldb * 2;
    int R[2], C[2];
    unsigned voffB[2];
#pragma unroll
    for (int i = 0; i < 2; ++i) { stage_rc(tid * 16 + i * 8192, R[i], C[i]); voffB[i] = (unsigned)(R[i] * ldbB + C[i] * 2); }
    const size_t kstep = (size_t)(BK * 2);
    const size_t hstepB = (size_t)HALF * ldbB;
    const unsigned ldsw = (unsigned)wid * 1024u;
    const int aoff = lds_byte(wr * 64 + fr, fq * 8), boff = lds_byte(wc * 32 + fr, fq * 8);
#define G8_SA(b, h) (((b) * 2 + (h)) * HTB)
#define G8_SB(b, h) ((4 + (b) * 2 + (h)) * HTB)
#define G8_STAGE(bufoff, gbase, voff) do { if constexpr (PROBE != 2) _Pragma("unroll") for (int _i = 0; _i < 2; ++_i) \
        __builtin_amdgcn_global_load_lds((const unsigned*)((const char*)(gbase) + (voff)[_i]), (LAS unsigned*)(lds + (bufoff) + ldsw + _i * 8192), 16, 0, 0); } while (0)
#define G8_RD16(off) __builtin_bit_cast(v4i, *(const LAS bf16x8*)(lds + (off)))
#define G8_LDA(dst, b, h) do { if constexpr (P::FP8) { _Pragma("unroll") for (int m = 0; m < 4; ++m) dst##8[m] = __builtin_shufflevector(G8_RD16(G8_SA(b, h) + aoff + m * 2048), G8_RD16(G8_SA(b, h) + aoff + m * 2048 + 1024), 0, 1, 2, 3, 4, 5, 6, 7); } \
        else { _Pragma("unroll") for (int m = 0; m < 4; ++m) _Pragma("unroll") for (int k = 0; k < 2; ++k) dst[m][k] = *(const LAS bf16x8*)(lds + G8_SA(b, h) + aoff + m * 2048 + k * 1024); } } while (0)
#define G8_LDB(dst, b, h) do { if constexpr (P::FP8) { _Pragma("unroll") for (int n = 0; n < 2; ++n) dst##8[n] = __builtin_shufflevector(G8_RD16(G8_SB(b, h) + boff + n * 2048), G8_RD16(G8_SB(b, h) + boff + n * 2048 + 1024), 0, 1, 2, 3, 4, 5, 6, 7); } \
        else { _Pragma("unroll") for (int n = 0; n < 2; ++n) _Pragma("unroll") for (int k = 0; k < 2; ++k) dst[n][k] = *(const LAS bf16x8*)(lds + G8_SB(b, h) + boff + n * 2048 + k * 1024); } } while (0)
#define G8_MMA(ai, bj, At, Bt) do { if constexpr (PROBE == 1) break; __builtin_amdgcn_s_setprio(1); \
        if constexpr (P::FP8) { _Pragma("unroll") for (int m = 0; m < 4; ++m) _Pragma("unroll") for (int n = 0; n < 2; ++n) \
            asm volatile("v_mfma_f32_16x16x128_f8f6f4 %0, %1, %2, %0" : "+v"(acc[ai][bj][m][n]) : "v"(Bt##8[n]), "v"(At##8[m])); } \
        else { _Pragma("unroll") for (int m = 0; m < 4; ++m) _Pragma("unroll") for (int n = 0; n < 2; ++n) _Pragma("unroll") for (int k = 0; k < 2; ++k) \
            acc[ai][bj][m][n] = __builtin_amdgcn_mfma_f32_16x16x32_bf16(Bt[n][k], At[m][k], acc[ai][bj][m][n], 0, 0, 0); } \
        __builtin_amdgcn_s_setprio(0); } while (0)
#define G8_WAIT_V(n) asm volatile("s_waitcnt vmcnt(" #n ")" ::: "memory")
#define G8_WAIT_L(n) asm volatile("s_waitcnt lgkmcnt(" #n ")" ::: "memory")
#define G8_BAR __builtin_amdgcn_s_barrier()
#define G8_SCHED __builtin_amdgcn_sched_barrier(0)
    Unit cur, nxt; int ui = 0;
    if (!p.next(0, cur)) return;
    f32x4 acc[2][2][4][2];
#pragma unroll
    for (int a = 0; a < 2; ++a)
#pragma unroll
        for (int b = 0; b < 2; ++b)
#pragma unroll
            for (int m = 0; m < 4; ++m)
#pragma unroll
                for (int n = 0; n < 2; ++n) acc[a][b][m][n] = (f32x4){0.f, 0.f, 0.f, 0.f};
    bf16x8 At[4][2], B0[2][2], B1[2][2]; v8i At8[4], B08[2], B18[2];
    unsigned oc0[2], oc1[2], on0[2], on1[2];
    int sl = 0;
    if constexpr (P::GATHER) { if (wid == 0) { p.tok_issue(cur, 0, lane); Unit u1; if (p.next(1, u1)) p.tok_issue(u1, 1, lane); }
        asm volatile("s_waitcnt vmcnt(0)" ::: "memory"); __builtin_amdgcn_s_barrier(); asm volatile("" ::: "memory"); }
    p.aoff(cur, 0, R, C, oc0, oc1);
    const char* cA = cur.A; const char* cB = cur.B;
    G8_STAGE(G8_SB(0, 0), cB, voffB); G8_STAGE(G8_SB(0, 1), cB + hstepB, voffB); G8_STAGE(G8_SA(0, 0), cA, oc0); G8_STAGE(G8_SA(0, 1), cA, oc1);
    if (wr == 1) G8_BAR;
    G8_WAIT_V(2); G8_BAR;
    G8_STAGE(G8_SB(1, 0), cB + kstep, voffB); G8_STAGE(G8_SA(1, 0), cA + kstep, oc0); G8_STAGE(G8_SB(1, 1), cB + hstepB + kstep, voffB);
    G8_WAIT_V(6); G8_BAR;
    for (;;) {
        const bool has_next = p.next(ui + 1, nxt);
        const int sl1 = sl == 2 ? 0 : sl + 1, sl2 = sl1 == 2 ? 0 : sl1 + 1;
        if (wid == 0) { p.vec_issue(cur, ui & 1, lane); if constexpr (P::GATHER) { Unit u2; if (p.next(ui + 2, u2)) p.tok_issue(u2, sl2, lane); } }
        if (has_next) p.aoff(nxt, sl1, R, C, on0, on1); else { on0[0] = oc0[0]; on0[1] = oc0[1]; on1[0] = oc1[0]; on1[1] = oc1[1]; }
        const char* nA = has_next ? nxt.A : cA; const char* nB = has_next ? nxt.B : cB;
        for (int t = 0; t < nt; t += 2) {
            const bool last = (t == nt - 2);
            const char* a1 = cA + (size_t)(t + 1) * kstep;
            const char* a2 = last ? nA : cA + (size_t)(t + 2) * kstep; const char* b2 = last ? nB : cB + (size_t)(t + 2) * kstep;
            const char* a3 = a2 + kstep; const char* b3 = b2 + kstep;
            unsigned o20[2], o21[2];
            o20[0] = last ? on0[0] : oc0[0]; o20[1] = last ? on0[1] : oc0[1]; o21[0] = last ? on1[0] : oc1[0]; o21[1] = last ? on1[1] : oc1[1];
            G8_LDB(B0, 0, 0); G8_LDB(B1, 0, 1); G8_SCHED; G8_LDA(At, 0, 0); G8_STAGE(G8_SA(1, 1), a1, oc1);
            G8_WAIT_V(8); G8_WAIT_L(0); G8_BAR; G8_MMA(0, 0, At, B0); G8_MMA(0, 1, At, B1); G8_BAR; G8_SCHED;
            G8_LDA(At, 0, 1); G8_STAGE(G8_SB(0, 0), b2, voffB); G8_STAGE(G8_SB(0, 1), b2 + hstepB, voffB); G8_STAGE(G8_SA(0, 0), a2, o20);
            G8_WAIT_V(8); G8_WAIT_L(0); G8_BAR; G8_MMA(1, 0, At, B0); G8_MMA(1, 1, At, B1); G8_BAR; G8_SCHED;
            G8_LDB(B0, 1, 0); G8_LDB(B1, 1, 1); G8_SCHED; G8_LDA(At, 1, 0); G8_STAGE(G8_SA(0, 1), a2, o21);
            G8_WAIT_V(8); G8_WAIT_L(0); G8_BAR; G8_MMA(0, 0, At, B0); G8_MMA(0, 1, At, B1); G8_BAR; G8_SCHED;
            G8_LDA(At, 1, 1); G8_STAGE(G8_SB(1, 0), b3, voffB); G8_STAGE(G8_SB(1, 1), b3 + hstepB, voffB); G8_STAGE(G8_SA(1, 0), a3, o20);
            G8_WAIT_V(8); G8_WAIT_L(0); G8_BAR; G8_MMA(1, 0, At, B0); G8_MMA(1, 1, At, B1); G8_BAR; G8_SCHED;
        }
        if (wr == 0) G8_BAR;
        if constexpr (PROBE == 0) p.epi(acc, cur, ui & 1, wr, wc, fr, fq);
        else { float t = 0.f; _Pragma("unroll") for (int a = 0; a < 2; ++a) _Pragma("unroll") for (int b = 0; b < 2; ++b) _Pragma("unroll") for (int m = 0; m < 4; ++m) _Pragma("unroll") for (int n = 0; n < 2; ++n) t += acc[a][b][m][n].x + acc[a][b][m][n].y + acc[a][b][m][n].z + acc[a][b][m][n].w;
            if (t == 123.456f) ((float*)p.probe_sink())[0] = t; }
        if (!has_next) break;
#pragma unroll
        for (int a = 0; a < 2; ++a)
#pragma unroll
            for (int b = 0; b < 2; ++b)
#pragma unroll
                for (int m = 0; m < 4; ++m)
#pragma unroll
                    for (int n = 0; n < 2; ++n) acc[a][b][m][n] = (f32x4){0.f, 0.f, 0.f, 0.f};
        cur = nxt; cA = nA; cB = nB; ++ui; sl = sl1;
        oc0[0] = on0[0]; oc0[1] = on0[1]; oc1[0] = on1[0]; oc1[1] = on1[1];
        if (wr == 1) G8_BAR;
    }
    G8_WAIT_V(0);
    G8_BAR;
#undef G8_SA
#undef G8_SB
#undef G8_STAGE
#undef G8_LDA
#undef G8_LDB
#undef G8_RD16
#undef G8_MMA
#undef G8_WAIT_V
#undef G8_WAIT_L
#undef G8_BAR
#undef G8_SCHED
}
}

struct Args { const float* in[33]; float* out; unsigned char* ws; int ph_lo, ph_hi; };
enum { I_X = 0, I_C, I_CTX, I_CCTX, I_WADA, I_BADA, I_GMIX, I_GFFN, I_ARE, I_AIM, I_LOGDT, I_BRE, I_BIM, I_CRE, I_CIM, I_SD, I_WGLU, I_BGLU,
       I_WQKV, I_WO, I_QGAIN, I_KGAIN, I_LQ1, I_LK1, I_LQ2, I_LK2, I_SUBG, I_WR, I_BR, I_WGU, I_BGU, I_WDN, I_BDN };
struct Ctx {
    const float* const* in; float* out; unsigned char* ws; ldsp lds;
    int tid, lane, wave, blk, G;
};
__device__ __forceinline__ const float* modp(const Ctx& F, int layer, int row) { return (const float*)(F.ws + WS_MOD) + ((size_t)layer * 17 + row) * 6144; }
__device__ __forceinline__ const float* in_row(const Ctx& F, int r) {
    const int b = r / SB, s = r - b * SB;
    return s < CTXL ? F.in[I_CTX] + ((size_t)b * CTXL + s) * DM : F.in[I_X] + ((size_t)b * LSEQ + (s - CTXL)) * DM;
}

__device__ __forceinline__ int rowmap_glu(int n) { const int half = n >> 10, c = n & 1023; return 256 * (c >> 7) + 128 * half + (c & 127); }
__device__ __forceinline__ int rowmap_gu(int n) { const int half = n >> 10, c = n & 1023, w = c & 127; return 256 * (c >> 7) + 128 * half + (w & ~31) + g8::slot_of_col32(w & 31); }
__device__ __forceinline__ int rowmap_dn(int n) { return (n & ~31) + g8::slot_of_col32(n & 31); }
__device__ __forceinline__ int rowmap_qkv(int n) {
    if (n >= 2048) return n;
    const int tile = n >> 8, t = n & 255, wc = t >> 6, i = t & 63, bj = i >> 5;
    return 256 * tile + 128 * bj + 32 * wc + g8::slot_of_col32(i & 31);
}
__device__ __forceinline__ unsigned pk4_fp8(float a, float b, float c, float d) { int w = 0; w = __builtin_amdgcn_cvt_pk_fp8_f32(a, b, w, false); w = __builtin_amdgcn_cvt_pk_fp8_f32(c, d, w, true); return (unsigned)w; }
template <int MAP, bool FP8>
__device__ __forceinline__ void transpose_item(const float* W, int N, unsigned char* WT, LAS unsigned* scr, int item, int lane, float scale) {
    const int nblk = N / 64, kb = item / nblk, nb = item % nblk, k0 = 64 * kb, n0 = 64 * nb, q = lane >> 4, L = lane & 15;
    f32x4 v[16];
#pragma unroll
    for (int i = 0; i < 16; ++i) { const int row = FP8 ? 16 * (i >> 2) + 4 * q + (i & 3) : 8 * (i >> 1) + 2 * q + (i & 1); v[i] = __builtin_nontemporal_load((const f32x4*)(W + (size_t)(k0 + row) * N + n0 + 4 * L)); }
    if (FP8) {
#pragma unroll
        for (int j = 0; j < 4; ++j)
#pragma unroll
            for (int x = 0; x < 4; ++x) scr[(4 * L + x) * 17 + 4 * j + q] = pk4_fp8(v[4 * j][x] * scale, v[4 * j + 1][x] * scale, v[4 * j + 2][x] * scale, v[4 * j + 3][x] * scale);
    } else {
#pragma unroll
        for (int j = 0; j < 8; ++j)
#pragma unroll
            for (int x = 0; x < 4; ++x) scr[(4 * L + x) * 33 + 4 * j + q] = pkbf(v[2 * j][x], v[2 * j + 1][x]);
    }
    LDS_WAIT(); asm volatile("" ::: "memory");
    if (FP8) {
#pragma unroll
        for (int i = 0; i < 4; ++i) { const int n = 16 * i + (lane >> 2), c = lane & 3; const LAS unsigned* sp = scr + n * 17 + 4 * c;
            const u32x4 o = {sp[0], sp[1], sp[2], sp[3]}; const int nn = n0 + n;
            const int row = MAP == 0 ? nn : MAP == 2 ? rowmap_qkv(nn) : MAP == 3 ? rowmap_gu(nn) : rowmap_dn(nn);
            *(u32x4*)(WT + (size_t)row * 1024 + k0 + 16 * c) = o; }
    } else {
#pragma unroll
        for (int i = 0; i < 8; ++i) { const int n = 8 * i + (lane >> 3), c = lane & 7; const LAS unsigned* sp = scr + n * 33 + 4 * c;
            const u32x4 o = {sp[0], sp[1], sp[2], sp[3]}; const int nn = n0 + n;
            const int row = MAP == 0 ? nn : MAP == 2 ? rowmap_qkv(nn) : MAP == 3 ? rowmap_gu(nn) : rowmap_dn(nn);
            *(u32x4*)(WT + (size_t)row * 2048 + (k0 + 8 * c) * 2) = o; }
    }
    LDS_WAIT(); asm volatile("" ::: "memory");
}

__device__ __forceinline__ void sincos_d(double x, double& s, double& c) {
    const double TWO_PI = 6.283185307179586476925; const double k = __builtin_rint(x / TWO_PI); double r = x - k * TWO_PI;
    r *= 0.125;
    const double r2 = r * r;
    double sn = r * (1.0 + r2 * (-1.0 / 6 + r2 * (1.0 / 120 + r2 * (-1.0 / 5040 + r2 * (1.0 / 362880 + r2 * (-1.0 / 39916800 + r2 * (1.0 / 6227020800.0)))))));
    double cs = 1.0 + r2 * (-0.5 + r2 * (1.0 / 24 + r2 * (-1.0 / 720 + r2 * (1.0 / 40320 + r2 * (-1.0 / 3628800 + r2 * (1.0 / 479001600.0 + r2 * (-1.0 / 87178291200.0)))))));
#pragma unroll
    for (int i = 0; i < 3; ++i) { const double s2 = 2.0 * sn * cs, c2 = cs * cs - sn * sn; sn = s2; cs = c2; }
    s = sn; c = cs;
}
__device__ __forceinline__ double exp_small_d(double x) {
    return 1.0 + x * (1.0 + x * (0.5 + x * (1.0 / 6 + x * (1.0 / 24 + x * (1.0 / 120 + x * (1.0 / 720 + x * (1.0 / 5040 + x * (1.0 / 40320 + x * (1.0 / 362880 + x * (1.0 / 3628800))))))))));
}

__device__ __forceinline__ void s5_prep_group(const Ctx& F, int g) {
    LAS float* lpw = (LAS float*)(F.lds);
    LAS float* bb  = (LAS float*)(F.lds + 17408);
    LAS float* cc  = (LAS float*)(F.lds + 17408 + 16384);
    LAS float* kt  = (LAS float*)(F.lds + 17408 + 32768);
    const int t = F.tid;
    if (t < 128) {
        const int d = t >> 6, p = t & 63; const size_t gp = ((size_t)d * 64 + g) * 64 + p;
        const double are = F.in[I_ARE][gp], aim = F.in[I_AIM][gp];
        const double dt = exp((double)F.in[I_LOGDT][d * 64 + g]);
        const double lr = are * dt, li = aim * dt;
        double sn, cs; sincos_d(li, sn, cs);
        const double mag = exp_small_d(lr);
        const double lamr = mag * cs, lami = mag * sn;
        const double nr = lamr - 1.0, ni = lami, den = are * are + aim * aim;
        const double zr = (nr * are + ni * aim) / den, zi = (ni * are - nr * aim) / den;
        double pr = 1.0, pi = 0.0;
#pragma unroll 1
        for (int k = 0; k <= 16; ++k) { lpw[((d * 64 + p) * 17 + k) * 2] = (float)pr; lpw[((d * 64 + p) * 17 + k) * 2 + 1] = (float)pi;
            const double qr = pr * lamr - pi * lami, qi = pr * lami + pi * lamr; pr = qr; pi = qi; }
        float* lamt = (float*)(F.ws + WS_LAMT) + (((size_t)g * 2 + d) * 64 + p) * 2;
        lamt[0] = lpw[((d * 64 + p) * 17 + 16) * 2]; lamt[1] = lpw[((d * 64 + p) * 17 + 16) * 2 + 1];
#pragma unroll
        for (int c = 0; c < 16; ++c) { const size_t bi = (((size_t)d * 64 + g) * 64 + p) * 16 + c; const double br = F.in[I_BRE][bi], bim = F.in[I_BIM][bi];
            bb[((d * 64 + p) * 16 + c) * 2] = (float)(zr * br - zi * bim); bb[((d * 64 + p) * 16 + c) * 2 + 1] = (float)(zr * bim + zi * br); }
    }
#pragma unroll
    for (int i = t; i < 2048; i += 512) { const int d = i >> 10, c = (i >> 6) & 15, p = i & 63; const size_t ci = (((size_t)d * 64 + g) * 16 + c) * 64 + p;
        cc[i * 2] = F.in[I_CRE][ci]; cc[i * 2 + 1] = F.in[I_CIM][ci]; }
    __syncthreads();
    {
        const int d = t >> 8, c = (t >> 4) & 15, c2 = t & 15;
        float kacc[16];
#pragma unroll
        for (int k = 0; k < 16; ++k) kacc[k] = 0.f;
#pragma unroll 1
        for (int p = 0; p < 64; ++p) {
            const float cr = cc[((d * 16 + c) * 64 + p) * 2], ci = cc[((d * 16 + c) * 64 + p) * 2 + 1];
            const float br = bb[((d * 64 + p) * 16 + c2) * 2], bi = bb[((d * 64 + p) * 16 + c2) * 2 + 1];
            const float lr = lpw[((d * 64 + p) * 17 + 1) * 2], li = lpw[((d * 64 + p) * 17 + 1) * 2 + 1];
            float wr = cr * br - ci * bi, wi = cr * bi + ci * br;
#pragma unroll
            for (int k = 0; k < 16; ++k) { kacc[k] += wr; const float nr = wr * lr - wi * li, ni = wr * li + wi * lr; wr = nr; wi = ni; }
        }
#pragma unroll
        for (int k = 0; k < 16; ++k) kt[(d * 16 + k) * 256 + c * 16 + c2] = kacc[k];
    }
    __syncthreads();
    bf16* acat = (bf16*)(F.ws + WS_ACAT) + (size_t)g * 256 * 512;
    const float* dsk = F.in[I_SD] + g * 16;
#pragma unroll 1
    for (int it = 0; it < 32; ++it) {
        const int idx = t + 512 * it, rho = idx >> 6, k0 = (idx & 63) * 8;
        const int N = (rho & ~31) + g8::col_of_slot32(rho & 31), j = N >> 4, c = N & 15;
        float v[8];
        if (k0 < 256) {
            const int i = k0 >> 4, c0 = k0 & 15;
#pragma unroll
            for (int q = 0; q < 8; ++q) { const int c2 = c0 + q;
                v[q] = j > i ? kt[(0 * 16 + (j - i)) * 256 + c * 16 + c2] : j < i ? kt[(1 * 16 + (i - j)) * 256 + c * 16 + c2]
                     : kt[c * 16 + c2] + kt[16 * 256 + c * 16 + c2] + (c == c2 ? dsk[c] : 0.f); }
        } else {
            const int d = k0 >= 384 ? 1 : 0, q0 = k0 - 256 - 128 * d, pw = d ? 16 - j : j + 1;
#pragma unroll
            for (int q = 0; q < 4; ++q) { const int p = (q0 >> 1) + q;
                const float cr = cc[((d * 16 + c) * 64 + p) * 2], ci = cc[((d * 16 + c) * 64 + p) * 2 + 1];
                const float lr = lpw[((d * 64 + p) * 17 + pw) * 2], li = lpw[((d * 64 + p) * 17 + pw) * 2 + 1];
                v[2 * q] = cr * lr - ci * li; v[2 * q + 1] = -(cr * li + ci * lr); }
        }
        u32x4 o; o.x = pk2(v[0], v[1]); o.y = pk2(v[2], v[3]); o.z = pk2(v[4], v[5]); o.w = pk2(v[6], v[7]);
        *(u32x4*)(acat + (size_t)rho * 512 + k0) = o;
    }
    bf16* fmat = (bf16*)(F.ws + WS_FMAT) + (size_t)g * 256 * 256;
#pragma unroll 1
    for (int it = 0; it < 16; ++it) {
        const int idx = t + 512 * it, n = idx >> 5, k0 = (idx & 31) * 8;
        const int d = n >> 7, p = (n & 127) >> 1, im = n & 1, i = k0 >> 4, c0 = k0 & 15, pw = d ? i : 15 - i;
        const float lr = lpw[((d * 64 + p) * 17 + pw) * 2], li = lpw[((d * 64 + p) * 17 + pw) * 2 + 1];
        float v[8];
#pragma unroll
        for (int q = 0; q < 8; ++q) { const float br = bb[((d * 64 + p) * 16 + c0 + q) * 2], bi = bb[((d * 64 + p) * 16 + c0 + q) * 2 + 1];
            v[q] = im ? lr * bi + li * br : lr * br - li * bi; }
        u32x4 o; o.x = pk2(v[0], v[1]); o.y = pk2(v[2], v[3]); o.z = pk2(v[4], v[5]); o.w = pk2(v[6], v[7]);
        *(u32x4*)(fmat + (size_t)n * 256 + k0) = o;
    }
    __syncthreads();
}

__device__ __forceinline__ void adaln_item(const Ctx& F, int item) {
    LAS float* sil = (LAS float*)(F.lds);
    LAS float* red = (LAS float*)(F.lds + 17 * 1024 * 4);
    { f32x4 t[9];
#pragma unroll
      for (int q = 0; q < 9; ++q) { const int i4 = F.tid + 512 * q; t[q] = i4 < 16 * 256 ? ((const f32x4*)F.in[I_C])[i4] : i4 < 17 * 256 ? ((const f32x4*)F.in[I_CCTX])[i4 - 16 * 256] : (f32x4){0.f, 0.f, 0.f, 0.f}; }
#pragma unroll
      for (int q = 0; q < 9; ++q) { const int i4 = F.tid + 512 * q; if (i4 < 17 * 256) ((LAS f32x4*)sil)[i4] = (f32x4){silu_f(t[q].x), silu_f(t[q].y), silu_f(t[q].z), silu_f(t[q].w)}; } }
    __syncthreads();
    const int li = item / 96, cb = item % 96, n = cb * 64 + F.lane;
    const float* W = F.in[I_WADA] + (size_t)li * 1024 * 6144 + n;
    float acc[17];
#pragma unroll
    for (int r = 0; r < 17; ++r) acc[r] = 0.f;
    const int kbeg = F.wave * 128;
#pragma unroll 8
    for (int k = kbeg; k < kbeg + 128; k += 4) {
        const float w0 = __builtin_nontemporal_load(W + (size_t)k * 6144), w1 = __builtin_nontemporal_load(W + (size_t)(k + 1) * 6144), w2 = __builtin_nontemporal_load(W + (size_t)(k + 2) * 6144), w3 = __builtin_nontemporal_load(W + (size_t)(k + 3) * 6144);
#pragma unroll
        for (int r = 0; r < 17; ++r) { const f32x4 s = *(const LAS f32x4*)(sil + r * 1024 + k); acc[r] += s.x * w0 + s.y * w1 + s.z * w2 + s.w * w3; }
    }
#pragma unroll
    for (int r = 0; r < 17; ++r) red[(F.wave * 17 + r) * 64 + F.lane] = acc[r];
    __syncthreads();
    for (int i = F.tid; i < 17 * 64; i += 512) { const int r = i >> 6, l = i & 63; float s = F.in[I_BADA][li * 6144 + cb * 64 + l];
#pragma unroll
        for (int w = 0; w < 8; ++w) s += red[(w * 17 + r) * 64 + l];
        ((float*)(F.ws + WS_MOD))[((size_t)li * 17 + r) * 6144 + cb * 64 + l] = s; }
    __syncthreads();
}

constexpr int TI_GLU = 16 * 32, TI_QKV = 16 * 48, TI_O = 16 * 16, TI_GU1 = 16 * 32, TI_DN1 = 16 * 16;
__device__ __forceinline__ void p0_prep(const Ctx& F) {
    for (int it = F.blk; it < 256; it += F.G) { if (it < 192) adaln_item(F, it); else s5_prep_group(F, it - 192); }
    LAS unsigned* scr = (LAS unsigned*)(F.lds + F.wave * 8448);
    const int gw = F.blk * 8 + F.wave, NGW = F.G * 8;
    for (int it = gw; it < TI_GLU + TI_QKV + TI_O; it += NGW) {
        int r = it;
        if (r < TI_GLU) { transpose_item<3, true>(F.in[I_WGLU], 2048, F.ws + WS_WGLU, scr, r, F.lane, W8_SCALE); continue; } r -= TI_GLU;
        if (r < TI_QKV) { transpose_item<2, false>(F.in[I_WQKV], 3072, F.ws + WS_WQKV, scr, r, F.lane, 1.f); continue; } r -= TI_QKV;
        transpose_item<4, true>(F.in[I_WO], 1024, F.ws + WS_WO, scr, r, F.lane, W8_SCALE);
    }
}
struct TrItem { const float* W; unsigned char* WT; int N, k0, n0, dn; };
__device__ __forceinline__ TrItem tr_decode(const Ctx& F, int it) {
    TrItem t; int r = it;
    if (r < 64 * TI_GU1) { const int le = r / TI_GU1, item = r - le * TI_GU1; t.W = F.in[I_WGU] + (size_t)le * 1024 * 2048; t.WT = F.ws + WS_WGU + (size_t)le * 2048 * 1024; t.N = 2048; t.dn = 0; t.k0 = 64 * (item >> 5); t.n0 = 64 * (item & 31); }
    else { r -= 64 * TI_GU1; const int le = r / TI_DN1, item = r - le * TI_DN1; t.W = F.in[I_WDN] + (size_t)le * 1024 * 1024; t.WT = F.ws + WS_WDN + (size_t)le * 1024 * 1024; t.N = 1024; t.dn = 1; t.k0 = 64 * (item >> 4); t.n0 = 64 * (item & 15); }
    return t;
}
__device__ __forceinline__ void tr_load(const TrItem& t, int lane, f32x4 (&v)[16]) {
    const int q = lane >> 4, L = lane & 15;
#pragma unroll
    for (int i = 0; i < 16; ++i) { const int row = 16 * (i >> 2) + 4 * q + (i & 3); v[i] = __builtin_nontemporal_load((const f32x4*)(t.W + (size_t)(t.k0 + row) * t.N + t.n0 + 4 * L)); }
}
__device__ __forceinline__ void tr_finish(const TrItem& t, int lane, const f32x4 (&v)[16], LAS unsigned* scr) {
    const int q = lane >> 4, L = lane & 15;
#pragma unroll
    for (int j = 0; j < 4; ++j)
#pragma unroll
        for (int x = 0; x < 4; ++x) scr[(4 * L + x) * 17 + 4 * j + q] = pk4_fp8(v[4 * j][x] * W8_SCALE, v[4 * j + 1][x] * W8_SCALE, v[4 * j + 2][x] * W8_SCALE, v[4 * j + 3][x] * W8_SCALE);
    LDS_WAIT(); asm volatile("" ::: "memory");
#pragma unroll
    for (int i = 0; i < 4; ++i) { const int n = 16 * i + (lane >> 2), c = lane & 3; const LAS unsigned* sp = scr + n * 17 + 4 * c;
        const u32x4 o = {sp[0], sp[1], sp[2], sp[3]}; const int nn = t.n0 + n; const int row = t.dn ? rowmap_dn(nn) : rowmap_gu(nn);
        __builtin_nontemporal_store(o, (u32x4*)(t.WT + (size_t)row * 1024 + t.k0 + 16 * c)); }
    LDS_WAIT(); asm volatile("" ::: "memory");
}
__device__ __forceinline__ void p0_moe_weights(const Ctx& F, int vb, int nvb) {
    LAS unsigned* scr = (LAS unsigned*)(F.lds + F.wave * 8448);
    const int gw = vb * 8 + F.wave, NGW = nvb * 8; constexpr int NIT = 64 * (TI_GU1 + TI_DN1);
    int it = gw; if (it >= NIT) return;
    TrItem cur = tr_decode(F, it); f32x4 va[16], vn[16];
    tr_load(cur, F.lane, va);
#pragma unroll 1
    for (;;) {
        const int nx = it + NGW; const bool has = nx < NIT; TrItem nxt = cur;
        if (has) { nxt = tr_decode(F, nx); tr_load(nxt, F.lane, vn); }
        tr_finish(cur, F.lane, va, scr);
        if (!has) break;
        it = nx; cur = nxt;
#pragma unroll
        for (int i = 0; i < 16; ++i) va[i] = vn[i];
    }
}

__device__ __forceinline__ void p1_norm0(const Ctx& F) {
    const int gw = F.blk * 8 + F.wave, NGW = F.G * 8;
    bf16* bcat = (bf16*)(F.ws + WS_BCAT);
    int r = gw; if (r >= NROW) return;
    f32x4 vn[4];
    { const f32x4* src = (const f32x4*)(in_row(F, r) + F.lane * 16);
#pragma unroll
      for (int j = 0; j < 4; ++j) vn[j] = src[j]; }
#pragma unroll 1
    for (;;) {
        const int b = r / SB, s = r - b * SB, r1 = r + NGW;
        f32x4 v[4]; float ss = 0.f;
#pragma unroll
        for (int j = 0; j < 4; ++j) { v[j] = vn[j]; ss += (v[j].x * v[j].x + v[j].y * v[j].y) + (v[j].z * v[j].z + v[j].w * v[j].w); }
        if (r1 < NROW) { const f32x4* src = (const f32x4*)(in_row(F, r1) + F.lane * 16);
#pragma unroll
            for (int j = 0; j < 4; ++j) vn[j] = src[j]; }
        const float rstd = rsqrtf(wave_sum(ss) * (1.f / DM) + NORM_EPS);
        const float* mod = modp(F, 0, s < CTXL ? 16 : b);
        const f32x4* sh = (const f32x4*)(mod + F.lane * 16); const f32x4* sc = (const f32x4*)(mod + 1024 + F.lane * 16); const f32x4* gg = (const f32x4*)(F.in[I_GMIX] + F.lane * 16);
        unsigned w[8];
#pragma unroll
        for (int j = 0; j < 4; ++j) { const f32x4 g = gg[j], c = sc[j], h = sh[j];
            const float a0 = v[j].x * rstd * g.x * (1.f + c.x) + h.x, a1 = v[j].y * rstd * g.y * (1.f + c.y) + h.y, a2 = v[j].z * rstd * g.z * (1.f + c.z) + h.z, a3 = v[j].w * rstd * g.w * (1.f + c.w) + h.w;
            w[2 * j] = pkbf(a0, a1); w[2 * j + 1] = pkbf(a2, a3); }
        u32x4* dst = (u32x4*)(bcat + (((size_t)F.lane * (NB * NCHUNK) + b * NCHUNK + (s >> 4)) * 512 + (s & 15) * 16));
        dst[0] = (u32x4){w[0], w[1], w[2], w[3]}; dst[1] = (u32x4){w[4], w[5], w[6], w[7]};
        if (r1 >= NROW) break;
        r = r1;
    }
}

__device__ __forceinline__ void p3_carry(const Ctx& F) {
    for (int id = F.blk * 512 + F.tid; id < 64 * NB * 2 * 64; id += F.G * 512) {
        const int p = id & 63, d = (id >> 6) & 1, b = (id >> 7) & 15, g = id >> 11;
        const float* lamt = (const float*)(F.ws + WS_LAMT) + (((size_t)g * 2 + d) * 64 + p) * 2;
        const float lr = lamt[0], li = lamt[1];
        const float* S = (const float*)(F.ws + WS_SBUF) + ((size_t)g * (NB * NCHUNK) + b * NCHUNK) * 256 + d * 128 + 2 * p;
        unsigned* H = (unsigned*)((bf16*)(F.ws + WS_BCAT) + ((size_t)g * (NB * NCHUNK) + b * NCHUNK) * 512 + 256 + d * 128 + 2 * p);
        float hr = 0.f, hi = 0.f;
#pragma unroll 1
        for (int q0 = 0; q0 < NCHUNK; q0 += 8) {
            f32x2 sv[8];
#pragma unroll
            for (int u = 0; u < 8; ++u) { const int q = q0 + u, k = d == 0 ? q : (q < 16 ? 15 - q : 159 - q); sv[u] = __builtin_nontemporal_load((const f32x2*)(S + (size_t)k * 256)); }
#pragma unroll
            for (int u = 0; u < 8; ++u) { const int q = q0 + u, k = d == 0 ? q : (q < 16 ? 15 - q : 159 - q);
                H[(size_t)k * 256] = pkbf(hr, hi);
                const float nr = lr * hr - li * hi + sv[u].x, ni = lr * hi + li * hr + sv[u].y; hr = nr; hi = ni; }
        }
    }
}

__device__ __forceinline__ void load_prefix(const Ctx& F, int layer) {
    LAS int* pref = (LAS int*)(F.lds + MISC_OFF + MO_PREF); LAS int* cnt = (LAS int*)(F.lds + MISC_OFF + MO_CNT);
    __syncthreads();
    if (F.tid < 32) cnt[F.tid] = (int)__hip_atomic_load((unsigned*)(F.ws + WS_CTL) + CW_CNT + (layer * 32 + F.tid) * 64, __ATOMIC_RELAXED, __HIP_MEMORY_SCOPE_AGENT);
    __syncthreads();
    if (F.tid == 0) { int a = 0; for (int e = 0; e < 32; ++e) { pref[e] = a; a += (cnt[e] + 255) >> 8; } pref[32] = a; }
    __syncthreads();
    LAS u32x2* tile_rec = (LAS u32x2*)(F.lds + MISC_OFF + MO_SEL);
    for (int t = F.tid; t < MAXTILES; t += 512) { int e = 0;
        for (int q = 1; q < 32; ++q) e = (pref[q] <= t) ? q : e;
        const int ti = t - pref[e];
        tile_rec[t] = (u32x2){(unsigned)(e | (ti << 8)), (unsigned)(cnt[e] - ti * 256)}; }
    __syncthreads();
}

template <int LAYER>
__device__ __forceinline__ void p_router(const Ctx& F) {
    constexpr int TS = 1028;
    LAS float* ht = (LAS float*)F.lds;
    LAS float* part = (LAS float*)(F.lds + 66048);
    LAS float* lgs = (LAS float*)(F.lds + 66048 + 16384);
    LAS float* pick = lgs + 512;
    LAS int* hist = (LAS int*)(F.lds + MISC_OFF + MO_HIST); LAS int* base = (LAS int*)(F.lds + MISC_OFF + MO_BASE);
    LAS int* sel_e = (LAS int*)(F.lds + MISC_OFF + MO_SEL); LAS int* sel_p = sel_e + 576; LAS float* sel_g = (LAS float*)(sel_p + 576);
    const int kg = F.lane >> 4, l15 = F.lane & 15;
    bf16x8 whi[4][2], wlo[4][2];
    { const float* wr = F.in[I_WR] + (size_t)LAYER * 1024 * 32;
#pragma unroll
      for (int ks = 0; ks < 4; ++ks)
#pragma unroll
        for (int nb = 0; nb < 2; ++nb) { float w[8];
#pragma unroll
            for (int j = 0; j < 8; ++j) w[j] = wr[(size_t)(128 * F.wave + 32 * ks + 8 * kg + j) * 32 + nb * 16 + l15];
            u32x4 h, l;
            h.x = pkbf(w[0], w[1]); h.y = pkbf(w[2], w[3]); h.z = pkbf(w[4], w[5]); h.w = pkbf(w[6], w[7]);
            l.x = pkbf(w[0] - bf_lo(h.x), w[1] - bf_hi(h.x)); l.y = pkbf(w[2] - bf_lo(h.y), w[3] - bf_hi(h.y)); l.z = pkbf(w[4] - bf_lo(h.z), w[5] - bf_hi(h.z)); l.w = pkbf(w[6] - bf_lo(h.w), w[7] - bf_hi(h.w));
            whi[ks][nb] = __builtin_bit_cast(bf16x8, h); wlo[ks][nb] = __builtin_bit_cast(bf16x8, l); } }
    constexpr int NR = LAYER == 0 ? 144 : 128, NSTEP = NR / 16;
    constexpr int NITEM = LAYER == 0 ? NROW / 144 : NLAT / 128;
    unsigned char* h2 = F.ws + WS_HB;
    const float brv = F.in[I_BR][LAYER * 32 + (F.tid & 31)];
#define RT_ROW(i) (LAYER == 0 ? item * 144 + (i) : (((item * 128 + (i)) >> 11) * SB + CTXL + ((item * 128 + (i)) & 2047)))
#define RT_LOAD(r, X, Y) do { const f32x4* _s = (const f32x4*)(LAYER == 0 ? in_row(F, r) : (const float*)(F.ws + WS_XS2) + (size_t)(r) * DM) + F.lane; \
        const u32x2* _y = (const u32x2*)((const bf16*)(F.ws + (LAYER == 0 ? WS_YG0 : WS_YG1)) + (size_t)(r) * DM) + F.lane; _Pragma("unroll") for (int j = 0; j < 4; ++j) { X[j] = _s[64 * j]; Y[j] = _y[64 * j]; } } while (0)
    for (int item = F.blk; item < NITEM; item += F.G) {
        if (F.tid < 32) hist[F.tid] = 0;
        f32x4 xn[2][4]; u32x2 yn[2][4];
        RT_LOAD(RT_ROW(2 * F.wave), xn[0], yn[0]); RT_LOAD(RT_ROW(2 * F.wave + 1), xn[1], yn[1]);
        __syncthreads();
#pragma unroll 1
        for (int st = 0; st < NSTEP; ++st) {
#pragma unroll
            for (int q = 0; q < 2; ++q) {
                const int i = st * 16 + 2 * F.wave + q, r = RT_ROW(i), b = r / SB, s = r - b * SB;
                f32x4 v[4];
#pragma unroll
                for (int j = 0; j < 4; ++j) { v[j] = xn[q][j]; v[j].x += bf_lo(yn[q][j].x); v[j].y += bf_hi(yn[q][j].x); v[j].z += bf_lo(yn[q][j].y); v[j].w += bf_hi(yn[q][j].y); }
                if (st + 1 < NSTEP) { const int r1 = RT_ROW(i + 16); RT_LOAD(r1, xn[q], yn[q]); }
                float ss = 0.f;
#pragma unroll
                for (int j = 0; j < 4; ++j) { ss += (v[j].x * v[j].x + v[j].y * v[j].y) + (v[j].z * v[j].z + v[j].w * v[j].w); }
                const float rstd = rsqrtf(wave_sum(ss) * (1.f / DM) + NORM_EPS);
                const float* mod = modp(F, LAYER, s < CTXL ? 16 : b);
                const f32x4* sh = (const f32x4*)(mod + 3072) + F.lane; const f32x4* sc = (const f32x4*)(mod + 4096) + F.lane; const f32x4* gg = (const f32x4*)(F.in[I_GFFN] + LAYER * 1024) + F.lane;
                unsigned* dst = (unsigned*)(h2 + (size_t)r * DM) + F.lane;
                LAS f32x4* hrow = (LAS f32x4*)(ht + (2 * F.wave + q) * TS) + F.lane;
#pragma unroll
                for (int j = 0; j < 4; ++j) { const f32x4 g = gg[64 * j], c = sc[64 * j], h = sh[64 * j];
                    v[j].x = v[j].x * rstd * g.x * (1.f + c.x) + h.x; v[j].y = v[j].y * rstd * g.y * (1.f + c.y) + h.y; v[j].z = v[j].z * rstd * g.z * (1.f + c.z) + h.z; v[j].w = v[j].w * rstd * g.w * (1.f + c.w) + h.w;
                    dst[64 * j] = pk4_fp8(v[j].x, v[j].y, v[j].z, v[j].w); hrow[64 * j] = v[j]; }
            }
            __syncthreads();
            { f32x4 acc0 = {0.f, 0.f, 0.f, 0.f}, acc1 = {0.f, 0.f, 0.f, 0.f};
#pragma unroll
              for (int ks = 0; ks < 4; ++ks) {
                const LAS f32x4* ap = (const LAS f32x4*)(ht + l15 * TS + 128 * F.wave + 32 * ks + 8 * kg);
                const f32x4 a0 = ap[0], a1 = ap[1];
                u32x4 h, l;
                h.x = pkbf(a0.x, a0.y); h.y = pkbf(a0.z, a0.w); h.z = pkbf(a1.x, a1.y); h.w = pkbf(a1.z, a1.w);
                l.x = pkbf(a0.x - bf_lo(h.x), a0.y - bf_hi(h.x)); l.y = pkbf(a0.z - bf_lo(h.y), a0.w - bf_hi(h.y)); l.z = pkbf(a1.x - bf_lo(h.z), a1.y - bf_hi(h.z)); l.w = pkbf(a1.z - bf_lo(h.w), a1.w - bf_hi(h.w));
                const bf16x8 ah = __builtin_bit_cast(bf16x8, h), al = __builtin_bit_cast(bf16x8, l);
                acc0 = __builtin_amdgcn_mfma_f32_16x16x32_bf16(ah, whi[ks][0], acc0, 0, 0, 0); acc0 = __builtin_amdgcn_mfma_f32_16x16x32_bf16(ah, wlo[ks][0], acc0, 0, 0, 0); acc0 = __builtin_amdgcn_mfma_f32_16x16x32_bf16(al, whi[ks][0], acc0, 0, 0, 0);
                acc1 = __builtin_amdgcn_mfma_f32_16x16x32_bf16(ah, whi[ks][1], acc1, 0, 0, 0); acc1 = __builtin_amdgcn_mfma_f32_16x16x32_bf16(ah, wlo[ks][1], acc1, 0, 0, 0); acc1 = __builtin_amdgcn_mfma_f32_16x16x32_bf16(al, whi[ks][1], acc1, 0, 0, 0);
              }
              LAS float* pw = part + F.wave * 512 + (4 * kg) * 32 + l15;
#pragma unroll
              for (int rr = 0; rr < 4; ++rr) { pw[rr * 32] = acc0[rr]; pw[rr * 32 + 16] = acc1[rr]; } }
            __syncthreads();
            { const int row = F.tid >> 5, e = F.tid & 31;
              float lg = brv;
#pragma unroll
              for (int w = 0; w < 8; ++w) lg += part[w * 512 + row * 32 + e];
              lgs[row * 32 + e] = lg;
              LDS_WAIT(); asm volatile("" ::: "memory");
              int rank = 0;
#pragma unroll
              for (int q = 0; q < 8; ++q) { const f32x4 o = *(const LAS f32x4*)(lgs + row * 32 + 4 * q);
                  rank += (int)((o.x > lg) | ((o.x == lg) & (4 * q + 0 < e))); rank += (int)((o.y > lg) | ((o.y == lg) & (4 * q + 1 < e)));
                  rank += (int)((o.z > lg) | ((o.z == lg) & (4 * q + 2 < e))); rank += (int)((o.w > lg) | ((o.w == lg) & (4 * q + 3 < e))); }
              asm volatile("" ::: "memory");
              if (rank < 4) { pick[(row * 4 + rank) * 2] = lg; ((LAS int*)pick)[(row * 4 + rank) * 2 + 1] = e; }
              LDS_WAIT(); asm volatile("" ::: "memory");
              if (e < 4) { const f32x4 t01 = *(const LAS f32x4*)(pick + row * 8), t23 = *(const LAS f32x4*)(pick + row * 8 + 4);
                  const float e1 = __expf(t01.z - t01.x), e2 = __expf(t23.x - t01.x), e3 = __expf(t23.z - t01.x), inv = 1.f / (1.f + e1 + e2 + e3);
                  const int ek = __builtin_bit_cast(int, e == 0 ? t01.y : e == 1 ? t01.w : e == 2 ? t23.y : t23.w);
                  const float gk = (e == 0 ? 1.f : e == 1 ? e1 : e == 2 ? e2 : e3) * inv;
                  const int lp = __hip_atomic_fetch_add(hist + ek, 1, __ATOMIC_RELAXED, __HIP_MEMORY_SCOPE_WORKGROUP);
                  const int i = st * 16 + row;
                  sel_e[i * 4 + e] = ek; sel_p[i * 4 + e] = lp; sel_g[i * 4 + e] = gk; } }
        }
        __syncthreads();
        if (F.tid < 32) base[F.tid] = (int)__hip_atomic_fetch_add((unsigned*)(F.ws + WS_CTL) + CW_CNT + (LAYER * 32 + F.tid) * 64, (unsigned)hist[F.tid], __ATOMIC_RELAXED, __HIP_MEMORY_SCOPE_AGENT);
        __syncthreads();
        for (int idx = F.tid; idx < NR * 4; idx += 512) { const int i = idx >> 2, r = RT_ROW(i);
            const int e = sel_e[idx], pos = base[e] + sel_p[idx];
            ((int*)(F.ws + WS_ROUTE_E))[(size_t)r * 4 + (idx & 3)] = e; ((int*)(F.ws + WS_ROUTE_P))[(size_t)r * 4 + (idx & 3)] = pos; ((float*)(F.ws + WS_ROUTE_G))[(size_t)r * 4 + (idx & 3)] = sel_g[idx];
            ((int*)(F.ws + WS_TOKL))[(size_t)e * NROW + pos] = r; }
        __syncthreads();
    }
#undef RT_ROW
#undef RT_LOAD
}

template <int LAYER>
__device__ __forceinline__ void p_combine(const Ctx& F) {
    load_prefix(F, LAYER);
    const LAS int* pref = (const LAS int*)(F.lds + MISC_OFF + MO_PREF);
    const int gw = F.blk * 8 + F.wave, NGW = F.G * 8;
    const unsigned char* ys = F.ws + WS_YS;
    const int* re = (const int*)(F.ws + WS_ROUTE_E); const int* rp = (const int*)(F.ws + WS_ROUTE_P); const float* rg = (const float*)(F.ws + WS_ROUTE_G);
    constexpr int NTOT = LAYER == 0 ? NROW : NLAT;
#define CMB_ROW(n) (LAYER == 0 ? (n) : ((n) >> 11) * SB + CTXL + ((n) & 2047))
#define CMB_ROUTE(r, RK, GK) do { _Pragma("unroll") for (int k = 0; k < 4; ++k) { const int e = re[(size_t)(r) * 4 + k], pos = rp[(size_t)(r) * 4 + k]; RK[k] = pref[e] * 256 + pos; GK[k] = rg[(size_t)(r) * 4 + k]; } } while (0)
#define CMB_LOAD(r, RK, X, Y, G) do { const f32x4* _s = (const f32x4*)(LAYER == 0 ? in_row(F, r) : (const float*)(F.ws + WS_XS2) + (size_t)(r) * DM) + F.lane; \
        const u32x2* _g = (const u32x2*)((const bf16*)(F.ws + (LAYER == 0 ? WS_YG0 : WS_YG1)) + (size_t)(r) * DM) + F.lane; _Pragma("unroll") for (int j = 0; j < 4; ++j) { X[j] = __builtin_nontemporal_load(_s + 64 * j); G[j] = __builtin_nontemporal_load(_g + 64 * j); \
        _Pragma("unroll") for (int k = 0; k < 4; ++k) Y[k][j] = __builtin_nontemporal_load((const unsigned*)(ys + (size_t)RK[k] * DM) + F.lane + 64 * j); } } while (0)
    int n0 = gw; if (n0 >= NTOT) return;
    int r0 = CMB_ROW(n0), rk0[4], rk1[4]; float gk0[4], gk1[4];
    f32x4 xa[4], xb[4]; unsigned ya[4][4], yb[4][4]; u32x2 ga[4], gb[4];
    CMB_ROUTE(r0, rk0, gk0);
    CMB_LOAD(r0, rk0, xa, ya, ga);
    int n1 = n0 + NGW, r1 = 0; bool has1 = n1 < NTOT;
    if (has1) { r1 = CMB_ROW(n1); CMB_ROUTE(r1, rk1, gk1); }
#pragma unroll 1
    for (;;) {
        if (has1) CMB_LOAD(r1, rk1, xb, yb, gb);
        const int n2 = n1 + NGW; const bool has2 = has1 && n2 < NTOT; int r2 = 0, rk2[4]; float gk2[4];
        if (has2) { r2 = CMB_ROW(n2); CMB_ROUTE(r2, rk2, gk2); }
        {
            const int r = r0, b = r / SB, s = r - b * SB;
            const float* mod = modp(F, LAYER, s < CTXL ? 16 : b);
            const f32x4* gt = (const f32x4*)(mod + 5120) + F.lane;
            f32x4 v[4];
#pragma unroll
            for (int j = 0; j < 4; ++j) {
                f32x4 a = {0.f, 0.f, 0.f, 0.f};
#pragma unroll
                for (int k = 0; k < 4; ++k) { const unsigned w = ya[k][j]; a.x += gk0[k] * __builtin_amdgcn_cvt_f32_fp8(w, 0); a.y += gk0[k] * __builtin_amdgcn_cvt_f32_fp8(w, 1); a.z += gk0[k] * __builtin_amdgcn_cvt_f32_fp8(w, 2); a.w += gk0[k] * __builtin_amdgcn_cvt_f32_fp8(w, 3); }
                const f32x4 g = gt[64 * j]; v[j] = xa[j] + g * a;
                v[j].x += bf_lo(ga[j].x); v[j].y += bf_hi(ga[j].x); v[j].z += bf_lo(ga[j].y); v[j].w += bf_hi(ga[j].y);
            }
            if (LAYER == 1) {
                f32x4* dst = (f32x4*)(F.out + ((size_t)b * LSEQ + (s - CTXL)) * DM) + F.lane;
#pragma unroll
                for (int j = 0; j < 4; ++j) __builtin_nontemporal_store(v[j], dst + 64 * j);
            } else {
                if (s >= CTXL) { f32x4* dst = (f32x4*)((float*)(F.ws + WS_XS2) + (size_t)r * DM) + F.lane;
#pragma unroll
                    for (int j = 0; j < 4; ++j) __builtin_nontemporal_store(v[j], dst + 64 * j); }
                float ss = 0.f;
#pragma unroll
                for (int j = 0; j < 4; ++j) ss += (v[j].x * v[j].x + v[j].y * v[j].y) + (v[j].z * v[j].z + v[j].w * v[j].w);
                const float rstd = rsqrtf(wave_sum(ss) * (1.f / DM) + NORM_EPS);
                const float* mod1 = modp(F, 1, s < CTXL ? 16 : b);
                const f32x4* sh = (const f32x4*)(mod1) + F.lane; const f32x4* sc = (const f32x4*)(mod1 + 1024) + F.lane; const f32x4* gg = (const f32x4*)(F.in[I_GMIX] + 1024) + F.lane;
                u32x2* dst = (u32x2*)((bf16*)(F.ws + WS_HB) + (size_t)r * DM) + F.lane;
#pragma unroll
                for (int j = 0; j < 4; ++j) { const f32x4 g = gg[64 * j], c = sc[64 * j], h = sh[64 * j];
                    dst[64 * j] = (u32x2){pkbf(v[j].x * rstd * g.x * (1.f + c.x) + h.x, v[j].y * rstd * g.y * (1.f + c.y) + h.y), pkbf(v[j].z * rstd * g.z * (1.f + c.z) + h.z, v[j].w * rstd * g.w * (1.f + c.w) + h.w)}; }
            }
        }
        if (!has1) break;
        r0 = r1; n1 = n2; r1 = r2; has1 = has2;
#pragma unroll
        for (int k = 0; k < 4; ++k) { rk0[k] = rk1[k]; gk0[k] = gk1[k]; rk1[k] = rk2[k]; gk1[k] = gk2[k]; }
#pragma unroll
        for (int j = 0; j < 4; ++j) { xa[j] = xb[j]; ga[j] = gb[j];
#pragma unroll
            for (int k = 0; k < 4; ++k) ya[k][j] = yb[k][j]; }
    }
#undef CMB_ROW
#undef CMB_ROUTE
#undef CMB_LOAD
}

using g8::Unit;
#define ACC_T const f32x4 (&acc)[2][2][4][2]
#define DENSE_AOFF(LDA) __device__ __forceinline__ void aoff(const Unit&, int, const int (&R)[2], const int (&C)[2], unsigned (&o0)[2], unsigned (&o1)[2]) const { \
    _Pragma("unroll") for (int i = 0; i < 2; ++i) { o0[i] = (unsigned)(R[i] * (LDA) + C[i]) * 2u; o1[i] = o0[i] + 128u * (LDA) * 2u; } }
#define DENSE_AOFF8(LDAB) __device__ __forceinline__ void aoff(const Unit&, int, const int (&R)[2], const int (&C)[2], unsigned (&o0)[2], unsigned (&o1)[2]) const { \
    _Pragma("unroll") for (int i = 0; i < 2; ++i) { o0[i] = (unsigned)(R[i] * (LDAB) + C[i] * 2); o1[i] = o0[i] + 128u * (LDAB); } }
#define NO_VEC __device__ __forceinline__ void vec_issue(const Unit&, int, int) const {}
__device__ __forceinline__ void glds16(const void* g, ldsp l) { __builtin_amdgcn_global_load_lds((const unsigned*)g, (LAS unsigned*)l, 16, 0, 0); }
template <int NT> __device__ __forceinline__ void moe_deal(int i, int G, int c, int& mt, int& pn) {
    constexpr int MT = 32 / NT;
    if (G == 256) { const int x = c & 7, j = c >> 3; mt = (i * 8 + x) * MT + j / NT; pn = j % NT; }
    else { const int L = i * G + c; mt = L / NT; pn = L % NT; }
}

struct PS5a {
    static constexpr bool GATHER = false, FP8 = false;
    int K, ldb, G, c; const char* bcat; const char* fmat; float* sbuf;
    __device__ __forceinline__ bool next(int i, Unit& u) const { const int L = i * G + c; if (L >= 576) return false; const int g = L / 9, pm = L - g * 9;
        u.A = bcat + ((size_t)g * 2304 + pm * 256) * 1024; u.B = fmat + (size_t)g * 256 * 256 * 2; u.pm = pm; u.pn = 0; u.e = g; u.cnt = 0; u.tb = 0; return true; }
    DENSE_AOFF(512) NO_VEC
    __device__ __forceinline__ void epi(ACC_T, const Unit& u, int, int wr, int wc, int fr, int fq) const {
        float* base = sbuf + ((size_t)u.e * 2304 + u.pm * 256 + wr * 64 + fr) * 256 + wc * 32 + 4 * fq;
#pragma unroll
        for (int ai = 0; ai < 2; ++ai)
#pragma unroll
            for (int m = 0; m < 4; ++m) { float* rowp = base + (size_t)(ai * 128 + m * 16) * 256;
#pragma unroll
                for (int bj = 0; bj < 2; ++bj)
#pragma unroll
                    for (int n = 0; n < 2; ++n) *(f32x4*)(rowp + bj * 128 + n * 16) = acc[ai][bj][m][n]; }
    }
};
struct PS5c {
    static constexpr bool GATHER = false, FP8 = false;
    int K, ldb, G, c; const char* bcat; const char* acat; unsigned char* yact;
    __device__ __forceinline__ bool next(int i, Unit& u) const { const int L = i * G + c; if (L >= 576) return false; const int g = L / 9, pm = L - g * 9;
        u.A = bcat + ((size_t)g * 2304 + pm * 256) * 1024; u.B = acat + (size_t)g * 256 * 512 * 2; u.pm = pm; u.pn = 0; u.e = g; u.cnt = 0; u.tb = 0; return true; }
    DENSE_AOFF(512) NO_VEC
    __device__ __forceinline__ void epi(ACC_T, const Unit& u, int, int wr, int wc, int fr, int fq) const {
#pragma unroll
        for (int ai = 0; ai < 2; ++ai)
#pragma unroll
            for (int m = 0; m < 4; ++m) { const int col = u.pm * 256 + ai * 128 + wr * 64 + m * 16 + fr, b = col / NCHUNK, ch = col - b * NCHUNK;
#pragma unroll
                for (int bj = 0; bj < 2; ++bj) { const int jt = 8 * bj + 2 * wc + (fq >> 1);
                    const f32x4 v0 = acc[ai][bj][m][0], v1 = acc[ai][bj][m][1];
                    *(u32x2*)(yact + ((size_t)b * SB + ch * 16 + jt) * DM + u.e * 16 + 8 * (fq & 1)) =
                        (u32x2){pk4_fp8(gelu_tanh(v0.x), gelu_tanh(v0.y), gelu_tanh(v0.z), gelu_tanh(v0.w)), pk4_fp8(gelu_tanh(v1.x), gelu_tanh(v1.y), gelu_tanh(v1.z), gelu_tanh(v1.w))}; } }
    }
};
struct PGlu {
    static constexpr bool GATHER = false, FP8 = true;
    __device__ __forceinline__ void* probe_sink() const { return (void*)(F->ws + WS_CTL + 512 * 1024); }
    int K, ldb, G, c; const char* A; const char* B; const Ctx* F;
    __device__ __forceinline__ bool next(int i, Unit& u) const { int pm, pn; if (!g8::static_order(i, G, c, 144, 8, pm, pn)) return false;
        u.A = A + (size_t)pm * 256 * 1024; u.B = B + (size_t)pn * 256 * 1024; u.pm = pm; u.pn = pn; u.e = 0; u.cnt = 0; u.tb = 0; return true; }
    DENSE_AOFF8(1024)
    __device__ __forceinline__ void vec_issue(const Unit& u, int slot, int lane) const {
        const int b = u.pm / 9; const bool isctx = (u.pm - b * 9) == 0; const ldsp dst = F->lds + MISC_OFF + MO_VEC + slot * 2048;
        glds16(F->in[I_BGLU] + (lane >> 5) * 1024 + u.pn * 128 + 4 * (lane & 31), dst);
        glds16(modp(*F, 0, isctx ? 16 : b) + 2048 + u.pn * 128 + 4 * (lane & 31), dst + 1024);
    }
    __device__ __forceinline__ void epi(ACC_T, const Unit& u, int slot, int wr, int wc, int fr, int fq) const {
        const LAS float* vec = (const LAS float*)(F->lds + MISC_OFF + MO_VEC + slot * 2048); const int cl = wc * 32 + 8 * fq;
        f32x4 ba[2], bg[2], gt[2];
#pragma unroll
        for (int n = 0; n < 2; ++n) { ba[n] = *(const LAS f32x4*)(vec + cl + 4 * n); bg[n] = *(const LAS f32x4*)(vec + 128 + cl + 4 * n); gt[n] = *(const LAS f32x4*)(vec + 256 + cl + 4 * n); }
        bf16* yg = (bf16*)(F->ws + WS_YG0);
#pragma unroll
        for (int ai = 0; ai < 2; ++ai)
#pragma unroll
            for (int m = 0; m < 4; ++m) { const int r = u.pm * 256 + ai * 128 + wr * 64 + m * 16 + fr;
                float o[8];
#pragma unroll
                for (int n = 0; n < 2; ++n) { const f32x4 a = acc[ai][0][m][n] * W8_INV + ba[n], g = acc[ai][1][m][n] * W8_INV + bg[n];
#pragma unroll
                    for (int j = 0; j < 4; ++j) o[4 * n + j] = gt[n][j] * a[j] * fast_sigmoid(g[j]); }
                u32x4 w; w.x = pkbf(o[0], o[1]); w.y = pkbf(o[2], o[3]); w.z = pkbf(o[4], o[5]); w.w = pkbf(o[6], o[7]);
                *(u32x4*)(yg + (size_t)r * DM + u.pn * 128 + cl) = w; }
    }
};
struct PMoeGu {
    static constexpr bool GATHER = true, FP8 = true;
    int K, ldb, G, c, layer; const Ctx* F; int ntiles;
    __device__ __forceinline__ bool next(int i, Unit& u) const { int mt, pn; moe_deal<8>(i, G, c, mt, pn); if (mt >= ntiles) return false;
        const u32x2 rec = ((const LAS u32x2*)(F->lds + MISC_OFF + MO_SEL))[mt]; const int e = (int)(rec.x & 255u);
        u.A = (const char*)(F->ws + WS_HB); u.B = (const char*)(F->ws + WS_WGU) + ((size_t)(layer * 32 + e) * 2048 + pn * 256) * 1024;
        u.pm = mt; u.pn = pn; u.e = e; u.cnt = (int)rec.y; u.tb = (int)(rec.x >> 8) * 256; return true; }
    __device__ __forceinline__ void tok_issue(const Unit& u, int slot, int lane) const {
        glds16((const int*)(F->ws + WS_TOKL) + (size_t)u.e * NROW + u.tb + 4 * lane, F->lds + MISC_OFF + MO_TOK + slot * 1024); }
    __device__ __forceinline__ void aoff(const Unit& u, int slot, const int (&R)[2], const int (&C)[2], unsigned (&o0)[2], unsigned (&o1)[2]) const {
        const LAS int* tl = (const LAS int*)(F->lds + MISC_OFF + MO_TOK + slot * 1024);
#pragma unroll
        for (int i = 0; i < 2; ++i) { const int t0 = R[i] < u.cnt ? tl[R[i]] : 0, t1 = (R[i] + 128) < u.cnt ? tl[R[i] + 128] : 0;
            o0[i] = (unsigned)(t0 * 1024 + C[i] * 2); o1[i] = (unsigned)(t1 * 1024 + C[i] * 2); }
    }
    __device__ __forceinline__ void vec_issue(const Unit& u, int slot, int lane) const {
        glds16(F->in[I_BGU] + (size_t)(layer * 32 + u.e) * 2048 + (lane >> 5) * 1024 + u.pn * 128 + 4 * (lane & 31), F->lds + MISC_OFF + MO_VEC + slot * 2048); }
    __device__ __forceinline__ void epi(ACC_T, const Unit& u, int slot, int wr, int wc, int fr, int fq) const {
        const LAS float* vec = (const LAS float*)(F->lds + MISC_OFF + MO_VEC + slot * 2048); const int cl = wc * 32 + 8 * fq;
        const f32x4 bg0 = *(const LAS f32x4*)(vec + cl), bg1 = *(const LAS f32x4*)(vec + cl + 4), bu0 = *(const LAS f32x4*)(vec + 128 + cl), bu1 = *(const LAS f32x4*)(vec + 128 + cl + 4);
        unsigned char* act = F->ws + WS_ACT;
#pragma unroll
        for (int ai = 0; ai < 2; ++ai)
#pragma unroll
            for (int m = 0; m < 4; ++m) { const int row = u.pm * 256 + ai * 128 + wr * 64 + m * 16 + fr;
                float o[8];
#pragma unroll
                for (int n = 0; n < 2; ++n) { const f32x4 gv = acc[ai][0][m][n] * W8_INV + (n ? bg1 : bg0), uv = acc[ai][1][m][n] * W8_INV + (n ? bu1 : bu0);
#pragma unroll
                    for (int j = 0; j < 4; ++j) { const float gt = fminf(gv[j], 7.0f), up = fminf(fmaxf(uv[j], -7.0f), 7.0f); o[4 * n + j] = (up + 1.0f) * gt * __builtin_amdgcn_rcpf(1.0f + __builtin_amdgcn_exp2f(-2.45546696f * gt)); } }
                *(u32x2*)(act + (size_t)row * DM + u.pn * 128 + cl) = (u32x2){pk4_fp8(o[0], o[1], o[2], o[3]), pk4_fp8(o[4], o[5], o[6], o[7])}; }
    }
};
struct PMoeDn {
    static constexpr bool GATHER = false, FP8 = true;
    int K, ldb, G, c, layer; const Ctx* F; int ntiles;
    __device__ __forceinline__ bool next(int i, Unit& u) const { int mt, pn; moe_deal<4>(i, G, c, mt, pn); if (mt >= ntiles) return false;
        const int e = (int)(((const LAS u32x2*)(F->lds + MISC_OFF + MO_SEL))[mt].x & 255u);
        u.A = (const char*)(F->ws + WS_ACT) + (size_t)mt * 256 * 1024; u.B = (const char*)(F->ws + WS_WDN) + ((size_t)(layer * 32 + e) * 1024 + pn * 256) * 1024;
        u.pm = mt; u.pn = pn; u.e = e; u.cnt = 0; u.tb = 0; return true; }
    __device__ __forceinline__ void aoff(const Unit&, int, const int (&R)[2], const int (&C)[2], unsigned (&o0)[2], unsigned (&o1)[2]) const {
#pragma unroll
        for (int i = 0; i < 2; ++i) { o0[i] = (unsigned)(R[i] * 1024 + C[i] * 2); o1[i] = o0[i] + 128u * 1024u; } }
    __device__ __forceinline__ void vec_issue(const Unit& u, int slot, int lane) const {
        glds16(F->in[I_BDN] + (size_t)(layer * 32 + u.e) * 1024 + u.pn * 256 + 4 * lane, F->lds + MISC_OFF + MO_VEC + slot * 2048); }
    __device__ __forceinline__ void epi(ACC_T, const Unit& u, int slot, int wr, int wc, int fr, int fq) const {
        const LAS float* vec = (const LAS float*)(F->lds + MISC_OFF + MO_VEC + slot * 2048); unsigned char* ys = F->ws + WS_YS;
#pragma unroll
        for (int bj = 0; bj < 2; ++bj) { const int cl = bj * 128 + wc * 32 + 8 * fq; const f32x4 b0 = *(const LAS f32x4*)(vec + cl), b1 = *(const LAS f32x4*)(vec + cl + 4);
#pragma unroll
            for (int ai = 0; ai < 2; ++ai)
#pragma unroll
                for (int m = 0; m < 4; ++m) { const int row = u.pm * 256 + ai * 128 + wr * 64 + m * 16 + fr; const f32x4 v0 = acc[ai][bj][m][0] * W8_INV + b0, v1 = acc[ai][bj][m][1] * W8_INV + b1;
                    *(u32x2*)(ys + (size_t)row * DM + u.pn * 256 + cl) = (u32x2){pk4_fp8(v0.x, v0.y, v0.z, v0.w), pk4_fp8(v1.x, v1.y, v1.z, v1.w)}; } }
    }
};
struct PQkv {
    static constexpr bool GATHER = false, FP8 = false;
    int K, ldb, G, c; const char* H; const char* W; const Ctx* F; bf16* vt;
    __device__ __forceinline__ bool next(int i, Unit& u) const { long L = (long)i * G + c; int pm, pn;
        if (L < 576) { g8::static_order_l(L, 144, 4, pm, pn); pn += 4; u.e = 0; }
        else if (L < 1088) { g8::static_order_l(L - 576, 128, 4, pm, pn); pm = (pm >> 3) * 9 + 1 + (pm & 7); u.e = 0; }
        else if (L < 1664) { g8::static_order_l(L - 1088, 4, 144, pm, pn); u.e = 1; }
        else return false;
        if (u.e == 0) { u.A = H + (size_t)pm * 256 * 2048; u.B = W + (size_t)pn * 256 * 2048; } else { u.A = W + (size_t)(2048 + pm * 256) * 2048; u.B = H + (size_t)pn * 256 * 2048; }
        u.pm = pm; u.pn = pn; u.cnt = 0; u.tb = 0; return true; }
    DENSE_AOFF(1024) NO_VEC
    __device__ __forceinline__ void epi(ACC_T, const Unit& u, int, int wr, int wc, int fr, int fq) const { if (u.e == 0) epi_qk(acc, u, wr, wc, fr, fq); else epi_vt(acc, u, wr, wc, fr, fq); }
    __device__ __forceinline__ void epi_qk(ACC_T, const Unit& u, int wr, int wc, int fr, int fq) const {
        const int b = u.pm / 9, t9 = u.pm - b * 9; const bool isctx = t9 == 0, isk = u.pn >= 4;
        if (!isk && isctx) return;
        const int hc = (u.pn & 3) * 4 + wc, h = hc >> 1, comp = hc & 1;
        const LAS float* gain = (const LAS float*)(F->lds + MISC_OFF + MO_GAIN) + (isk ? 64 : 0);
        const f32x4 g00 = *(const LAS f32x4*)(gain + 8 * fq), g01 = *(const LAS f32x4*)(gain + 8 * fq + 4), g10 = *(const LAS f32x4*)(gain + 32 + 8 * fq), g11 = *(const LAS f32x4*)(gain + 32 + 8 * fq + 4);
        const LAS f32x4* rope = (const LAS f32x4*)(F->lds + MISC_OFF + MO_SEL) + 4 * (fq & 1);
        const float oscale = isk ? 1.0f : 0.18033688011112042f;
        bf16* dstb = isk ? (bf16*)(F->ws + WS_K) + ((size_t)((b * 8 + h) * 2 + comp) * SB) * 64 : (bf16*)(F->ws + WS_Q) + ((size_t)((b * 8 + h) * 2 + comp) * LSEQ) * 64;
#pragma unroll
        for (int ai = 0; ai < 2; ++ai)
#pragma unroll
            for (int m = 0; m < 4; ++m) {
                const int s = t9 * 256 + ai * 128 + wr * 64 + m * 16 + fr;
                float ss = 0.f;
#pragma unroll
                for (int bj = 0; bj < 2; ++bj)
#pragma unroll
                    for (int n = 0; n < 2; ++n) { const f32x4 x = acc[ai][bj][m][n]; ss += (x.x * x.x + x.y * x.y) + (x.z * x.z + x.w * x.w); }
                ss += __shfl_xor(ss, 16); ss += __shfl_xor(ss, 32);
                const float rstd = rsqrtf(ss * (1.0f / 64.0f) + NORM_EPS);
                float v1[8], v2[8];
#pragma unroll
                for (int n = 0; n < 2; ++n)
#pragma unroll
                    for (int j = 0; j < 4; ++j) { v1[4 * n + j] = acc[ai][0][m][n][j] * rstd * (n ? g01[j] : g00[j]); v2[4 * n + j] = acc[ai][1][m][n][j] * rstd * (n ? g11[j] : g10[j]); }
                if (!isctx) {
                    const int pos = s - CTXL, pvi = (fq < 2) ? (pos >> 6) : (pos & 63);
#pragma unroll
                    for (int q2 = 0; q2 < 4; ++q2) { const f32x4 t = rope[pvi * 8 + q2];
                        { const float a = v1[2 * q2], bb2 = v2[2 * q2]; v1[2 * q2] = a * t.x - bb2 * t.y; v2[2 * q2] = bb2 * t.x + a * t.y; }
                        { const float a = v1[2 * q2 + 1], bb2 = v2[2 * q2 + 1]; v1[2 * q2 + 1] = a * t.z - bb2 * t.w; v2[2 * q2 + 1] = bb2 * t.z + a * t.w; } }
                }
                bf16* dst = dstb + (size_t)(isk ? s : s - CTXL) * 64 + 8 * fq;
                u32x4 w1, w2;
                w1.x = pkbf(v1[0] * oscale, v1[1] * oscale); w1.y = pkbf(v1[2] * oscale, v1[3] * oscale); w1.z = pkbf(v1[4] * oscale, v1[5] * oscale); w1.w = pkbf(v1[6] * oscale, v1[7] * oscale);
                w2.x = pkbf(v2[0] * oscale, v2[1] * oscale); w2.y = pkbf(v2[2] * oscale, v2[3] * oscale); w2.z = pkbf(v2[4] * oscale, v2[5] * oscale); w2.w = pkbf(v2[6] * oscale, v2[7] * oscale);
                *(u32x4*)dst = w1; *(u32x4*)(dst + 32) = w2;
            }
    }
    __device__ __forceinline__ void epi_vt(ACC_T, const Unit& u, int wr, int wc, int fr, int fq) const {
        const int b = u.pn / 9, s0 = (u.pn - b * 9) * 256 + wc * 32 + 8 * (fq & 1) + 4 * (fq >> 1);
#pragma unroll
        for (int ai = 0; ai < 2; ++ai)
#pragma unroll
            for (int m = 0; m < 4; ++m) { const int mrow = u.pm * 256 + ai * 128 + wr * 64 + m * 16 + fr; bf16* rowp = vt + ((size_t)b * 1024 + mrow) * SB + s0;
#pragma unroll
                for (int bj = 0; bj < 2; ++bj)
#pragma unroll
                    for (int n = 0; n < 2; ++n) { const f32x4 v = acc[ai][bj][m][n]; *(u32x2*)(rowp + bj * 128 + n * 16) = (u32x2){pkbf(v.x, v.y), pkbf(v.z, v.w)}; } }
    }
};
struct POut {
    static constexpr bool GATHER = false, FP8 = true;
    int K, ldb, G, c; const char* A; const char* B; const Ctx* F;
    __device__ __forceinline__ bool next(int i, Unit& u) const { int pm, pn; if (!g8::static_order(i, G, c, 128, 4, pm, pn)) return false;
        u.A = A + (size_t)pm * 256 * 1024; u.B = B + (size_t)pn * 256 * 1024; u.pm = pm; u.pn = pn; u.e = 0; u.cnt = 0; u.tb = 0; return true; }
    DENSE_AOFF8(1024)
    __device__ __forceinline__ void vec_issue(const Unit& u, int slot, int lane) const { glds16(modp(*F, 1, u.pm >> 3) + 2048 + u.pn * 256 + 4 * lane, F->lds + MISC_OFF + MO_VEC + slot * 2048); }
    __device__ __forceinline__ void epi(ACC_T, const Unit& u, int slot, int wr, int wc, int fr, int fq) const {
        const LAS float* vec = (const LAS float*)(F->lds + MISC_OFF + MO_VEC + slot * 2048); const int b = u.pm >> 3; bf16* yg = (bf16*)(F->ws + WS_YG1);
#pragma unroll
        for (int bj = 0; bj < 2; ++bj) { const int cl = bj * 128 + wc * 32 + 8 * fq; const f32x4 g0 = *(const LAS f32x4*)(vec + cl), g1 = *(const LAS f32x4*)(vec + cl + 4);
#pragma unroll
            for (int ai = 0; ai < 2; ++ai)
#pragma unroll
                for (int m = 0; m < 4; ++m) { const int nl = u.pm * 256 + ai * 128 + wr * 64 + m * 16 + fr; const size_t r = (size_t)b * SB + CTXL + (nl & 2047);
                    const f32x4 v0 = acc[ai][bj][m][0] * (g0 * W8_INV), v1 = acc[ai][bj][m][1] * (g1 * W8_INV);
                    u32x4 w; w.x = pkbf(v0.x, v0.y); w.y = pkbf(v0.z, v0.w); w.z = pkbf(v1.x, v1.y); w.w = pkbf(v1.z, v1.w);
                    *(u32x4*)(yg + r * DM + u.pn * 256 + cl) = w; } }
    }
};

__device__ __forceinline__ void attn_stage(const Ctx& F, const char* ubase, unsigned ustep, const unsigned (&off)[4], int buf) {
#pragma unroll
    for (int ii = 0; ii < 8; ++ii)
        __builtin_amdgcn_global_load_lds((const unsigned*)(ubase + (size_t)ii * ustep + off[ii & 3]), (LAS unsigned*)(F.lds + buf * 65536 + (F.wave * 8 + ii) * 1024), 16, 0, 0);
}
__device__ __forceinline__ void p_attn(const Ctx& F) {
    float lam;
    { const float a = F.in[I_LQ1][F.lane] * F.in[I_LK1][F.lane], b2 = F.in[I_LQ2][F.lane] * F.in[I_LK2][F.lane]; lam = __expf(wave_sum(a)) - __expf(wave_sum(b2)) + LAMBDA_INIT; }
    const int r = F.lane & 31, hh = F.lane >> 5, fsw = (r >> 1) & 7;
    unsigned soff[4];
    if (F.wave < 4) { const int row8 = F.lane >> 3, c0 = (F.lane & 7) ^ (row8 >> 1); soff[0] = soff[2] = row8 * 128 + c0 * 16; soff[1] = soff[3] = row8 * 128 + (c0 ^ 4) * 16; }
    else { const int row4 = F.lane >> 4, pos = F.lane & 15;
#pragma unroll
        for (int q = 0; q < 4; ++q) soff[q] = (unsigned)row4 * SB * 2u + (unsigned)((pos ^ (4 * q + row4)) << 4); }
    const int r15 = r & 15;
    const int vcu = (F.G % 8 == 0) ? (F.blk % 8) * (F.G / 8) + F.blk / 8 : F.blk;
    for (int un = vcu; un < NB * 8 * 8; un += F.G) {
        const int b = un >> 6, h = (un >> 3) & 7, qt = un & 7, q0 = qt * 256 + F.wave * 32;
        const bf16* Qb = (const bf16*)(F.ws + WS_Q) + ((size_t)((b * 8 + h) * 2) * LSEQ) * 64;
        const bf16* Kb = (const bf16*)(F.ws + WS_K) + ((size_t)((b * 8 + h) * 2) * SB) * 64;
        const bf16* Vb = (const bf16*)(F.ws + WS_VT) + ((size_t)(b * 8 + h) * 128) * SB;
        bf16x8 qf[2][4];
#pragma unroll
        for (int comp = 0; comp < 2; ++comp)
#pragma unroll
            for (int ds = 0; ds < 4; ++ds) qf[comp][ds] = *(const bf16x8*)(Qb + ((size_t)comp * LSEQ + q0 + r) * 64 + 16 * ds + 8 * hh);
        f32x16 o1[4], o2[4];
#pragma unroll
        for (int d = 0; d < 4; ++d)
#pragma unroll
            for (int i = 0; i < 16; ++i) { o1[d][i] = 0.f; o2[d][i] = 0.f; }
        float l1 = 0.f, l2 = 0.f;
        const char* sbase = F.wave < 4 ? (const char*)Kb + ((size_t)(F.wave >> 1) * SB + 64 * (F.wave & 1)) * 128 : (const char*)Vb + (size_t)(32 * (F.wave - 4)) * SB * 2;
        const unsigned kadv = F.wave < 4 ? 128u * 128u : 128u * 2u, sstep = F.wave < 4 ? 1024u : 4u * SB * 2u;
        attn_stage(F, sbase, sstep, soff, 0);
#pragma unroll 1
        for (int kt = 0; kt < SB / 128; ++kt) {
            const int buf = kt & 1;
            if (kt + 1 < SB / 128) { attn_stage(F, sbase + (size_t)(kt + 1) * kadv, sstep, soff, buf ^ 1); asm volatile("s_waitcnt vmcnt(8)" ::: "memory"); }
            else asm volatile("s_waitcnt vmcnt(0)" ::: "memory");
            __builtin_amdgcn_s_barrier(); asm volatile("" ::: "memory");
            if (F.wave >= 4) __builtin_amdgcn_s_sleep(ATTN_SKEW);
            const ldsp base = F.lds + buf * 65536;
#pragma unroll
            for (int kb = 0; kb < 4; ++kb) {
                bf16x8 p1[2], p2[2];
                {
                    f32x16 s1, s2;
#pragma unroll
                    for (int i = 0; i < 16; ++i) { s1[i] = 0.f; s2[i] = 0.f; }
#pragma unroll
                    for (int ds = 0; ds < 4; ++ds) {
                        const int off = (32 * kb + r) * 128 + (((2 * ds + hh) ^ fsw) << 4);
                        const bf16x8 k1 = *(const LAS bf16x8*)(base + off), k2 = *(const LAS bf16x8*)(base + 16384 + off);
                        s1 = __builtin_amdgcn_mfma_f32_32x32x16_bf16(k1, qf[0][ds], s1, 0, 0, 0);
                        s2 = __builtin_amdgcn_mfma_f32_32x32x16_bf16(k2, qf[1][ds], s2, 0, 0, 0);
                    }
#pragma unroll
                    for (int i = 0; i < 16; ++i) { s1[i] = __builtin_amdgcn_exp2f(s1[i]); l1 += s1[i]; }
#pragma unroll
                    for (int s = 0; s < 2; ++s) { u32x4 a2;
                        a2.x = pkbf(s1[8 * s], s1[8 * s + 1]); a2.y = pkbf(s1[8 * s + 2], s1[8 * s + 3]); a2.z = pkbf(s1[8 * s + 4], s1[8 * s + 5]); a2.w = pkbf(s1[8 * s + 6], s1[8 * s + 7]);
                        p1[s] = __builtin_bit_cast(bf16x8, a2); }
#pragma unroll
                    for (int i = 0; i < 16; ++i) { s2[i] = __builtin_amdgcn_exp2f(s2[i]); l2 += s2[i]; }
#pragma unroll
                    for (int s = 0; s < 2; ++s) { u32x4 c2;
                        c2.x = pkbf(s2[8 * s], s2[8 * s + 1]); c2.y = pkbf(s2[8 * s + 2], s2[8 * s + 3]); c2.z = pkbf(s2[8 * s + 4], s2[8 * s + 5]); c2.w = pkbf(s2[8 * s + 6], s2[8 * s + 7]);
                        p2[s] = __builtin_bit_cast(bf16x8, c2); }
                }
                __builtin_amdgcn_sched_barrier(0);
#pragma unroll
                for (int dvb = 0; dvb < 4; ++dvb) {
#pragma unroll
                    for (int s = 0; s < 2; ++s) {
                        const bf16x8 vf = *(const LAS bf16x8*)(base + 32768 + (32 * dvb + r) * 256 + (((4 * kb + 2 * s + hh) ^ r15) << 4));
                        o1[dvb] = __builtin_amdgcn_mfma_f32_32x32x16_bf16(vf, p1[s], o1[dvb], 0, 0, 0);
                        o2[dvb] = __builtin_amdgcn_mfma_f32_32x32x16_bf16(vf, p2[s], o2[dvb], 0, 0, 0);
                    }
                }
            }
            asm volatile("s_waitcnt lgkmcnt(0)" ::: "memory");
            __builtin_amdgcn_s_barrier(); asm volatile("" ::: "memory");
        }
        l1 += __shfl_xor(l1, 32); l2 += __shfl_xor(l2, 32);
        const float i1 = 1.0f / l1, i2 = lam / l2;
        float ss = 0.f;
#pragma unroll
        for (int d = 0; d < 4; ++d)
#pragma unroll
            for (int i = 0; i < 16; ++i) { const float v = o1[d][i] * i1 - o2[d][i] * i2; o1[d][i] = v; ss += v * v; }
        ss += __shfl_xor(ss, 32);
        const float rstd = rsqrtf(ss * (1.0f / 128.0f) + NORM_EPS) * (1.0f - LAMBDA_INIT);
        unsigned char* orow = F.ws + WS_OATT + ((size_t)b * LSEQ + q0 + r) * DM + h * 128;
#pragma unroll
        for (int d = 0; d < 4; ++d)
#pragma unroll
            for (int g4 = 0; g4 < 4; ++g4) { const int dv = 32 * d + 8 * g4 + 4 * hh; const f32x4 sg = *(const f32x4*)(F.in[I_SUBG] + dv);
                *(unsigned*)(orow + dv) = pk4_fp8(o1[d][4 * g4] * rstd * sg.x, o1[d][4 * g4 + 1] * rstd * sg.y, o1[d][4 * g4 + 2] * rstd * sg.z, o1[d][4 * g4 + 3] * rstd * sg.w); }
    }
}

__global__ void __launch_bounds__(512, 2) mk_fwd(Args args) {
    extern __shared__ __attribute__((aligned(16))) unsigned char lds_raw[];
    Ctx F; F.in = args.in; F.out = args.out; F.ws = args.ws; F.lds = (ldsp)lds_raw;
    F.tid = threadIdx.x; F.lane = F.tid & 63; F.wave = __builtin_amdgcn_readfirstlane(F.tid >> 6); F.blk = blockIdx.x; F.G = gridDim.x;
    volatile LAS unsigned* misc = (volatile LAS unsigned*)(F.lds + MISC_OFF);
    if (F.tid < 8) misc[F.tid] = 0u;
    __syncthreads();
    unsigned* ctl = (unsigned*)(F.ws + WS_CTL);
    XcdBarrier bar; bar.bar = ctl + CW_BAR; bar.x = 0; bar.st = misc; bar.total = gridDim.x;
    const int lo = args.ph_lo, hi = args.ph_hi;
    if (hi - lo > 1) bar = xcd_barrier_post(ctl + CW_BAR, misc, gridDim.x);
#ifndef PH_MASK
#define PH_MASK 0xFFFFFFFFu
#endif
#define IN(k) (((PH_MASK >> (k)) & 1u) && lo <= (k) && (k) < hi)
#define SEAM(k) do { if (IN(k) && IN((k) + 1)) xcd_barrier(bar); } while (0)
    const LAS int* pref = (const LAS int*)(F.lds + MISC_OFF + MO_PREF); const LAS int* cnt = (const LAS int*)(F.lds + MISC_OFF + MO_CNT);
    const char* ws = (const char*)F.ws;

#ifndef DUP_MASK
#define DUP_MASK 0u
#endif
#define RUNPH(k, ...) do { if (IN(k)) { __VA_ARGS__ if ((DUP_MASK >> (k)) & 1u) { xcd_barrier(bar); __VA_ARGS__ } } SEAM(k); } while (0)
#if MK_ONE_LAUNCH
    if (lo == 0 && hi == NPHASE && F.G == 256) {
        p0_prep(F); xcd_barrier(bar);
        const int nA = SPLIT_A * 8, nB = F.G - nA;
        if (F.blk < nA) {
            XcdBarrier barA = xcd_barrier_post(ctl + CW_BAR2, misc + 4, (unsigned)nA);
            Ctx FA = F; FA.G = nA;
            p1_norm0(FA); xcd_barrier(barA);
            { PS5a P{256, 256, FA.G, FA.blk, ws + WS_BCAT, ws + WS_FMAT, (float*)(F.ws + WS_SBUF)}; g8::gemm_phase(F.lds, P); } xcd_barrier(barA);
            p3_carry(FA); xcd_barrier(barA);
            { PS5c P{512, 512, FA.G, FA.blk, ws + WS_BCAT, ws + WS_ACAT, F.ws + WS_HB}; g8::gemm_phase(F.lds, P); }
        } else p0_moe_weights(F, F.blk - nA, nB);
        xcd_barrier(bar);
    } else
#endif
    {
    RUNPH(0, { p0_prep(F); p0_moe_weights(F, F.blk, F.G); });
    RUNPH(1, { p1_norm0(F); });
    RUNPH(2, { PS5a P{256, 256, F.G, F.blk, ws + WS_BCAT, ws + WS_FMAT, (float*)(F.ws + WS_SBUF)}; g8::gemm_phase(F.lds, P); });
    RUNPH(3, { p3_carry(F); });
    RUNPH(4, { PS5c P{512, 512, F.G, F.blk, ws + WS_BCAT, ws + WS_ACAT, F.ws + WS_HB}; g8::gemm_phase(F.lds, P); });
    }
    RUNPH(5, { PGlu P{1024, 1024, F.G, F.blk, ws + WS_HB, ws + WS_WGLU, &F}; g8::gemm_phase(F.lds, P); });
#ifdef GEMM_PROBE
    if (IN(5)) { PGlu P{1024, 1024, F.G, F.blk, ws + WS_HB, ws + WS_WGLU, &F}; g8::gemm_phase<PGlu, GEMM_PROBE>(F.lds, P); xcd_barrier(bar); }
#endif
    if (IN(6)) { p_router<0>(F); if ((DUP_MASK >> 6) & 1u) { xcd_barrier(bar); if (F.blk == 0 && F.tid < 32) __hip_atomic_store(ctl + CW_CNT + F.tid * 64, 0u, __ATOMIC_RELAXED, __HIP_MEMORY_SCOPE_AGENT); xcd_barrier(bar); p_router<0>(F); } } SEAM(6);
    RUNPH(7, { load_prefix(F, 0); PMoeGu P{1024, 1024, F.G, F.blk, 0, &F, pref[32]}; g8::gemm_phase(F.lds, P); });
    RUNPH(8, { load_prefix(F, 0); PMoeDn P{1024, 1024, F.G, F.blk, 0, &F, pref[32]}; g8::gemm_phase(F.lds, P); });
    RUNPH(9, { p_combine<0>(F); });
    RUNPH(10, { if (F.tid < 128) ((LAS float*)(F.lds + MISC_OFF + MO_GAIN))[F.tid] = F.tid < 64 ? F.in[I_QGAIN][F.tid] : F.in[I_KGAIN][F.tid - 64];
                for (int i = F.tid; i < 1024; i += 512) { const float ang = (float)(i >> 4) * __expf(-9.210340371976184f * (float)(i & 15) * (1.0f / 16.0f)); ((LAS f32x2*)(F.lds + MISC_OFF + MO_SEL))[i] = (f32x2){__cosf(ang), __sinf(ang)}; }
                __syncthreads();
                { PQkv P{1024, 1024, F.G, F.blk, ws + WS_HB, ws + WS_WQKV, &F, (bf16*)(F.ws + WS_VT)}; g8::gemm_phase(F.lds, P); } });
    RUNPH(11, { p_attn(F); });
    RUNPH(12, { POut P{1024, 1024, F.G, F.blk, ws + WS_OATT, ws + WS_WO, &F}; g8::gemm_phase(F.lds, P); });
    RUNPH(13, { p_router<1>(F); });
    RUNPH(14, { load_prefix(F, 1); PMoeGu P{1024, 1024, F.G, F.blk, 1, &F, pref[32]}; g8::gemm_phase(F.lds, P); });
    RUNPH(15, { load_prefix(F, 1); PMoeDn P{1024, 1024, F.G, F.blk, 1, &F, pref[32]}; g8::gemm_phase(F.lds, P); });
    if (IN(16)) { p_combine<1>(F); if ((DUP_MASK >> 16) & 1u) { xcd_barrier(bar); p_combine<1>(F); } }
#undef RUNPH
#undef IN
#undef SEAM
}

extern "C" void kernel_launch(void* const* d_in, const int* in_sizes, int n_in, void* d_out, int out_size, void* d_ws, size_t ws_size, hipStream_t stream) {
    static int grid = 0;
    if (grid == 0) {
        if (n_in != 33 || in_sizes[0] != NLAT * DM || out_size != NLAT * DM || ws_size < WS_END) { fprintf(stderr, "kernel_launch: unexpected problem (n_in %d, ws %zu); nothing launched\n", n_in, ws_size); grid = -1; return; }
        int dev = 0, cus = 0, per_cu = 0;
        if (hipGetDevice(&dev) != hipSuccess || hipDeviceGetAttribute(&cus, hipDeviceAttributeMultiprocessorCount, dev) != hipSuccess) { grid = -1; return; }
        if (hipFuncSetAttribute((const void*)mk_fwd, hipFuncAttributeMaxDynamicSharedMemorySize, LDS_BYTES) != hipSuccess) { fprintf(stderr, "kernel_launch: hipFuncSetAttribute failed\n"); grid = -1; return; }
        if (hipOccupancyMaxActiveBlocksPerMultiprocessor(&per_cu, (const void*)mk_fwd, 512, LDS_BYTES) != hipSuccess || per_cu < 1) fprintf(stderr, "kernel_launch: note: occupancy query reports %d\n", per_cu);
        (void)hipGetLastError();
        grid = cus;
    }
    if (grid < 0) return;
    if (hipMemsetAsync((char*)d_ws + WS_CTL, 0, CTL_ZERO_BYTES, stream) != hipSuccess) return;
    Args a{};
    for (int i = 0; i < 33; ++i) a.in[i] = (const float*)d_in[i];
    a.out = (float*)d_out; a.ws = (unsigned char*)d_ws;
#if MK_ONE_LAUNCH
    a.ph_lo = 0; a.ph_hi = NPHASE;
    hipLaunchKernelGGL(mk_fwd, dim3(grid), dim3(512), LDS_BYTES, stream, a);
#else
    for (int p = 0; p < NPHASE; ++p) { a.ph_lo = p; a.ph_hi = p + 1; hipLaunchKernelGGL(mk_fwd, dim3(grid), dim3(512), LDS_BYTES, stream, a); }
#endif
}
```

```cpp
#include <hip/hip_runtime.h>
#include <cstdio>
#include <cstdint>

#define LAS __attribute__((address_space(3)))
#define GAS __attribute__((address_space(1)))
typedef unsigned short bf16;
typedef short bf16x8 __attribute__((ext_vector_type(8)));
typedef short s16x4 __attribute__((ext_vector_type(4)));
typedef float f32x4 __attribute__((ext_vector_type(4)));
typedef float f32x2 __attribute__((ext_vector_type(2)));
typedef float f32x16 __attribute__((ext_vector_type(16)));
typedef unsigned u32x4 __attribute__((ext_vector_type(4)));
typedef unsigned u32x2 __attribute__((ext_vector_type(2)));
typedef int i32x4 __attribute__((ext_vector_type(4)));
typedef LAS unsigned char* ldsp;
typedef int v8i __attribute__((ext_vector_type(8)));
typedef int v4i __attribute__((ext_vector_type(4)));

#ifndef MK_ONE_LAUNCH
#define MK_ONE_LAUNCH 1
#endif
#ifndef SPLIT_A
#define SPLIT_A 18
#endif

constexpr int NB = 16, LSEQ = 2048, CTXL = 256, DM = 1024, SB = LSEQ + CTXL, NROW = NB * SB, NLAT = NB * LSEQ;
constexpr int NEXP = 32, TOPK = 4;
constexpr int NCHUNK = SB / 16;
constexpr int MAXTILES = NROW * TOPK / 256 + NEXP;
constexpr int ACT_ROWS = MAXTILES * 256;
constexpr int NPHASE = 17;
constexpr float NORM_EPS = 1e-6f;
constexpr float LAMBDA_INIT = 0.35550906759f;
constexpr float W8_SCALE = 32.0f, W8_INV = 1.0f / 32.0f;

constexpr size_t MiB = 1u << 20;
constexpr size_t WS_CTL = 0, CTL_ZERO_BYTES = 1 * MiB;
constexpr size_t WS_MOD = 1 * MiB;
constexpr size_t WS_LAMT = 2 * MiB;
constexpr size_t WS_ROUTE_E = 3 * MiB;
constexpr size_t WS_ROUTE_P = 4 * MiB;
constexpr size_t WS_ROUTE_G = 5 * MiB;
constexpr size_t WS_TOKL = 6 * MiB;
constexpr size_t WS_WGLU = 16 * MiB, WS_WQKV = 20 * MiB, WS_WO = 26 * MiB, WS_ACAT = 28 * MiB, WS_FMAT = 44 * MiB;
constexpr size_t WS_WGU = 64 * MiB;
constexpr size_t WS_WDN = 320 * MiB;
constexpr size_t WS_XS1 = 448 * MiB;
constexpr size_t WS_XS2 = 592 * MiB;
constexpr size_t WS_HB = 736 * MiB;
constexpr size_t WS_ACT = 808 * MiB;
constexpr size_t WS_YS = 1112 * MiB;
constexpr size_t WS_BCAT = 1416 * MiB;
constexpr size_t WS_SBUF = 1560 * MiB;
constexpr size_t WS_YG0 = WS_SBUF, WS_YG1 = WS_BCAT;
constexpr size_t WS_Q = WS_BCAT, WS_K = WS_BCAT + 64 * MiB, WS_VT = WS_SBUF, WS_OATT = WS_SBUF + 72 * MiB;
constexpr size_t WS_END = 1704 * MiB;
static_assert((size_t)ACT_ROWS * 2048 <= 304 * MiB, "act rows");
constexpr int CW_BAR = 4096;
constexpr int CW_BAR2 = 8192;
constexpr int CW_CNT = 16384;

constexpr int STAGE_BYTES = 131072;
constexpr int MISC_OFF = STAGE_BYTES + 1024;
constexpr int LDS_BYTES = MISC_OFF + 16384;
constexpr int MO_BAR = 0;
constexpr int MO_PREF = 64;
constexpr int MO_CNT = 256;
constexpr int MO_HIST = 512;
constexpr int MO_BASE = 768;
constexpr int MO_SEL = 1024;
constexpr int MO_VEC = 8192;
constexpr int MO_TOK = 12288;
constexpr int MO_GAIN = 15360;

#define LDS_WAIT() asm volatile("s_waitcnt lgkmcnt(0)" ::: "memory")
#define VM_WAIT() asm volatile("s_waitcnt vmcnt(0)" ::: "memory")
__device__ __forceinline__ unsigned f2bf(float f) { unsigned u = __builtin_bit_cast(unsigned, f); return (u + 0x7fffu + ((u >> 16) & 1u)) >> 16; }
__device__ __forceinline__ unsigned pk2(float lo, float hi) { return f2bf(lo) | (f2bf(hi) << 16); }
__device__ __forceinline__ unsigned cvt_pk_bf16(float lo, float hi) { unsigned r; asm volatile("v_cvt_pk_bf16_f32 %0, %1, %2" : "=v"(r) : "v"(lo), "v"(hi)); return r; }
typedef __bf16 bf2_t __attribute__((ext_vector_type(2)));
__device__ __forceinline__ unsigned pkbf(float lo, float hi) { f32x2 v = {lo, hi}; return __builtin_bit_cast(unsigned, __builtin_convertvector(v, bf2_t)); }
__device__ __forceinline__ float bf_lo(unsigned w) { return __builtin_bit_cast(float, w << 16); }
__device__ __forceinline__ float bf_hi(unsigned w) { return __builtin_bit_cast(float, w & 0xffff0000u); }
template <int LAYER> struct XRowT { typedef f32x4 T; };
template <> struct XRowT<1> { typedef u32x2 T; };
__device__ __forceinline__ f32x4 x_wide(const f32x4 v) { return v; }
__device__ __forceinline__ f32x4 x_wide(const u32x2 w) { return (f32x4){bf_lo(w.x), bf_hi(w.x), bf_lo(w.y), bf_hi(w.y)}; }
__device__ __forceinline__ int fresh_lane() { int ln; asm volatile("v_mbcnt_lo_u32_b32 %0, -1, 0\n\tv_mbcnt_hi_u32_b32 %0, -1, %0" : "=v"(ln)); return ln; }
__device__ __forceinline__ float wave_sum(float v) {
#pragma unroll
    for (int o = 1; o < 64; o <<= 1) v += __shfl_xor(v, o);
    return v;
}
__device__ __forceinline__ float fast_sigmoid(float x) { return __builtin_amdgcn_rcpf(1.0f + __builtin_amdgcn_exp2f(-1.44269504089f * x)); }
__device__ __forceinline__ float silu_f(float x) { return x / (1.0f + __expf(-x)); }
__device__ __forceinline__ float gelu_tanh(float x) {
    const float t = 1.5957691216f * (x + 0.044715f * x * x * x);
    return x * fast_sigmoid(t);
}

#define XB_TMO      128
#define XB_XCNT(j)  (256  + 64 * (j))
#define XB_XSUB(j)  (1280 + 64 * (j))
#define XB_XGEN(j)  (2304 + 64 * (j))
#define XB_TOP      3328
#define XB_TOPGEN   3392
#define XCD_BAR_WORDS 3456
#define XB_SPIN_CAP (1u << 18)
__device__ __forceinline__ unsigned xb_ld(unsigned* p)              { return __hip_atomic_load(p, __ATOMIC_RELAXED, __HIP_MEMORY_SCOPE_AGENT); }
__device__ __forceinline__ unsigned xb_add(unsigned* p, unsigned v) { return __hip_atomic_fetch_add(p, v, __ATOMIC_RELAXED, __HIP_MEMORY_SCOPE_AGENT); }
__device__ __forceinline__ unsigned xb_xcc_id() { return (unsigned)__builtin_amdgcn_s_getreg((3 << 11) | 20) & 0xFu; }
#define XB_SPIN(cond, bar) do { unsigned _sp = 0; while (cond) { __builtin_amdgcn_s_sleep(1); \
    if ((++_sp & 255u) == 0u) { if (xb_ld(&(bar)[XB_TMO])) break; if (_sp > XB_SPIN_CAP) { atomicAdd(&(bar)[XB_TMO], 1u); break; } } } } while (0)
struct XcdBarrier { unsigned* bar; unsigned x; volatile LAS unsigned* st; unsigned total; unsigned w; };
__device__ __forceinline__ XcdBarrier xcd_barrier_post(unsigned* bar, volatile LAS unsigned* st, unsigned total, unsigned w) {
    XcdBarrier b; b.bar = bar; b.x = xb_xcc_id(); b.st = st; b.total = total; b.w = w;
    if (w == 0u && fresh_lane() == 0) (void)xb_add(&bar[XB_XCNT(b.x)], 1u);
    return b;
}
__device__ __forceinline__ void xcd_barrier_complete(unsigned* bar, unsigned x, unsigned G, unsigned& nloc, unsigned& nx) {
    unsigned sum, cnt, mine, sp = 0u;
    for (;;) {
        sum = 0u; cnt = 0u; mine = 0u;
#pragma unroll
        for (unsigned j = 0; j < 16; ++j) { const unsigned c = xb_ld(&bar[XB_XCNT(j)]); sum += c; cnt += (c > 0u) ? 1u : 0u; mine = (j == x) ? c : mine; }
        if (sum == G) break;
        __builtin_amdgcn_s_sleep(1);
        if ((++sp & 255u) == 0u) { if (xb_ld(&bar[XB_TMO])) break; if (sp > XB_SPIN_CAP) { atomicAdd(&bar[XB_TMO], 1u); break; } }
    }
    nloc = mine > 0u ? mine : 1u; nx = cnt > 0u ? cnt : 1u;
}
__device__ __forceinline__ void xcd_barrier(const XcdBarrier& b) {
    asm volatile("s_waitcnt vmcnt(0)" ::: "memory");
    __syncthreads();
    const unsigned xln = (unsigned)fresh_lane();
    if (b.w == 0u && b.st[0] == 0u) {
        unsigned* bar = b.bar; const unsigned ln = xln; unsigned sp = 0u, c = 0u, sum = 0u;
        for (;;) {
            c = ln < 16u ? xb_ld(&bar[XB_XCNT(ln)]) : 0u;
            sum = c;
#pragma unroll
            for (int o = 1; o < 16; o <<= 1) sum += __shfl_xor(sum, o);
            sum = __builtin_amdgcn_readfirstlane(sum);
            if (sum == b.total) break;
            __builtin_amdgcn_s_sleep(1);
            if ((++sp & 255u) == 0u) { if (xb_ld(&bar[XB_TMO])) break; if (sp > XB_SPIN_CAP) { if (ln == 0u) atomicAdd(&bar[XB_TMO], 1u); break; } }
        }
        const unsigned long long nz = __ballot(c > 0u);
        const unsigned cnt = (unsigned)__popcll(nz), mine = (unsigned)__builtin_amdgcn_readlane((int)c, (int)b.x);
        if (ln == 0u) { b.st[0] = mine > 0u ? mine : 1u; b.st[1] = cnt > 0u ? cnt : 1u; }
        asm volatile("s_waitcnt lgkmcnt(0)" ::: "memory");
    }
    if (b.w == 0u && xln == 0u) {
        unsigned* bar = b.bar;
        __builtin_amdgcn_s_waitcnt(0);
        unsigned nloc = b.st[0], nx = b.st[1];
        if (nloc == 0u) { xcd_barrier_complete(bar, b.x, b.total, nloc, nx); b.st[0] = nloc; b.st[1] = nx; }
        const unsigned old = xb_add(&bar[XB_XSUB(b.x)], 1u);
        const unsigned gen = old / nloc;
        if (old + 1u == (gen + 1u) * nloc) {
            __builtin_amdgcn_fence(__ATOMIC_RELEASE, "agent");
            asm volatile("s_waitcnt vmcnt(0)" ::: "memory");
            const unsigned og = xb_add(&bar[XB_TOP], 1u);
            const unsigned tg = og / nx;
            if (og + 1u == (tg + 1u) * nx) xb_add(&bar[XB_TOPGEN], 1u);
            else XB_SPIN(xb_ld(&bar[XB_TOPGEN]) == tg, bar);
            __builtin_amdgcn_fence(__ATOMIC_ACQUIRE, "agent");
            xb_add(&bar[XB_XGEN(b.x)], 1u);
            asm volatile("s_waitcnt vmcnt(0)" ::: "memory");
        } else {
            XB_SPIN(xb_ld(&bar[XB_XGEN(b.x)]) == gen, bar);
            __builtin_amdgcn_fence(__ATOMIC_ACQUIRE, "agent");
            asm volatile("s_waitcnt vmcnt(0)" ::: "memory");
        }
    }
    __syncthreads();
}

namespace g8 {
constexpr int BM = 256, BK = 64, HALF = 128, HTB = HALF * BK * 2;
__host__ __device__ __forceinline__ int lds_byte(int r, int c) { const int st = (r >> 4) * 2 + (c >> 5), rr = r & 15, cc = c & 31, ob = rr * 64 + cc * 2; return st * 1024 + (ob ^ (((ob >> 9) & 1) << 5)); }
__host__ __device__ __forceinline__ void stage_rc(int b, int& R, int& C) { const int st = b / 1024, sb = b % 1024, swz = sb ^ (((sb >> 9) & 1) << 5); R = (st >> 1) * 16 + swz / 64; C = (st & 1) * 32 + (swz % 64) / 2; }
__host__ __device__ __forceinline__ int col_of_slot32(int s) { const int n = s >> 4, i = s & 15; return 8 * (i >> 2) + 4 * n + (i & 3); }
__host__ __device__ __forceinline__ int slot_of_col32(int c) { return 16 * ((c >> 2) & 1) + 4 * (c >> 3) + (c & 3); }

struct Unit { const char* A; const char* B; int pm, pn, e, cnt, tb; };

__device__ __forceinline__ bool static_order_l(long L, int nM, int nN, int& pm, int& pn) {
    const int nwg = nM * nN; if (L >= nwg) return false;
    int wgid = (int)L; { const int q = nwg / 8, r = nwg % 8, xcd = wgid % 8, off = wgid / 8; wgid = (xcd < r ? xcd * (q + 1) : r * (q + 1) + (xcd - r) * q) + off; }
    const int nig = 8 * nN, gid = wgid / nig, fm = gid * 8, gsz = (nM - fm) < 8 ? (nM - fm) : 8;
    pm = fm + ((wgid % nig) % gsz); pn = (wgid % nig) / gsz; return true;
}

__device__ __forceinline__ bool static_order(int i, int G, int c, int nM, int nN, int& pm, int& pn) { return static_order_l((long)i * G + c, nM, nN, pm, pn); }

template <class P, int PROBE = 0>
__device__ __forceinline__ void gemm_phase(ldsp lds, const P& p, int wid) {
    const int lane = fresh_lane(), tid = wid * 64 + lane, wr = wid >> 2, wc = wid & 3, fr = lane & 15, fq = lane >> 4;
    const int nt = (P::FP8 ? p.K : p.K * 2) / 128;
    const int ldbB = P::FP8 ? p.ldb : p.ldb * 2;
    int R[2], C[2];
    unsigned voffB[2];
#pragma unroll
    for (int i = 0; i < 2; ++i) { stage_rc(tid * 16 + i * 8192, R[i], C[i]); voffB[i] = (unsigned)(R[i] * ldbB + C[i] * 2); }
    const size_t kstep = (size_t)(BK * 2);
    const size_t hstepB = (size_t)HALF * ldbB;
    const unsigned ldsw = (unsigned)wid * 1024u;
    const int aoff = lds_byte(wr * 64 + fr, fq * 8), boff = lds_byte(wc * 32 + fr, fq * 8);
#define G8_SA(b, h) (((b) * 2 + (h)) * HTB)
#define G8_SB(b, h) ((4 + (b) * 2 + (h)) * HTB)
#define G8_STAGE(bufoff, gbase, voff) do { if constexpr (PROBE != 2) _Pragma("unroll") for (int _i = 0; _i < 2; ++_i) \
        __builtin_amdgcn_global_load_lds((const unsigned*)((const char*)(gbase) + (voff)[_i]), (LAS unsigned*)(lds + (bufoff) + ldsw + _i * 8192), 16, 0, 0); } while (0)
#define G8_RD16(off) __builtin_bit_cast(v4i, *(const LAS bf16x8*)(lds + (off)))
#define G8_LDA(dst, b, h) do { if constexpr (P::FP8) { _Pragma("unroll") for (int m = 0; m < 4; ++m) dst##8[m] = __builtin_shufflevector(G8_RD16(G8_SA(b, h) + aoff + m * 2048), G8_RD16(G8_SA(b, h) + aoff + m * 2048 + 1024), 0, 1, 2, 3, 4, 5, 6, 7); } \
        else { _Pragma("unroll") for (int m = 0; m < 4; ++m) _Pragma("unroll") for (int k = 0; k < 2; ++k) dst[m][k] = *(const LAS bf16x8*)(lds + G8_SA(b, h) + aoff + m * 2048 + k * 1024); } } while (0)
#define G8_LDB(dst, b, h) do { if constexpr (P::FP8) { _Pragma("unroll") for (int n = 0; n < 2; ++n) dst##8[n] = __builtin_shufflevector(G8_RD16(G8_SB(b, h) + boff + n * 2048), G8_RD16(G8_SB(b, h) + boff + n * 2048 + 1024), 0, 1, 2, 3, 4, 5, 6, 7); } \
        else { _Pragma("unroll") for (int n = 0; n < 2; ++n) _Pragma("unroll") for (int k = 0; k < 2; ++k) dst[n][k] = *(const LAS bf16x8*)(lds + G8_SB(b, h) + boff + n * 2048 + k * 1024); } } while (0)
#define G8_MMA(ai, bj, At, Bt) do { if constexpr (PROBE == 1) break; __builtin_amdgcn_s_setprio(1); \
        if constexpr (P::FP8) { _Pragma("unroll") for (int m = 0; m < 4; ++m) _Pragma("unroll") for (int n = 0; n < 2; ++n) \
            asm volatile("v_mfma_f32_16x16x128_f8f6f4 %0, %1, %2, %0" : "+v"(acc[ai][bj][m][n]) : "v"(Bt##8[n]), "v"(At##8[m])); } \
        else { _Pragma("unroll") for (int m = 0; m < 4; ++m) _Pragma("unroll") for (int n = 0; n < 2; ++n) _Pragma("unroll") for (int k = 0; k < 2; ++k) \
            acc[ai][bj][m][n] = __builtin_amdgcn_mfma_f32_16x16x32_bf16(Bt[n][k], At[m][k], acc[ai][bj][m][n], 0, 0, 0); } \
        __builtin_amdgcn_s_setprio(0); } while (0)
#define G8_MMA0(ai, bj, At, Bt) do { if constexpr (PROBE == 1) break; __builtin_amdgcn_s_setprio(1); \
        _Pragma("unroll") for (int m = 0; m < 4; ++m) _Pragma("unroll") for (int n = 0; n < 2; ++n) \
            asm volatile("v_mfma_f32_16x16x128_f8f6f4 %0, %1, %2, 0" : "=v"(acc[ai][bj][m][n]) : "v"(Bt##8[n]), "v"(At##8[m])); \
        __builtin_amdgcn_s_setprio(0); } while (0)
#define G8_WAIT_V(n) asm volatile("s_waitcnt vmcnt(" #n ")" ::: "memory")
#define G8_WAIT_VE(loose) asm volatile("s_cmp_eq_u32 %0, 0\n\ts_cbranch_scc1 .Lve_a%=\n\ts_waitcnt vmcnt(%1)\n\ts_branch .Lve_b%=\n.Lve_a%=:\n\ts_waitcnt vmcnt(8)\n.Lve_b%=:" :: "s"(__builtin_amdgcn_readfirstlane((int)(loose))), "n"(8 + P::EPI_VM) : "memory", "scc")
#define G8_WAIT_L(n) asm volatile("s_waitcnt lgkmcnt(" #n ")" ::: "memory")
#define G8_BAR __builtin_amdgcn_s_barrier()
#define G8_SCHED __builtin_amdgcn_sched_barrier(0)
    Unit cur, nxt; int ui = 0;
    if (!p.next(0, cur)) return;
    f32x4 acc[2][2][4][2];
#pragma unroll
    for (int a = 0; a < 2; ++a)
#pragma unroll
        for (int b = 0; b < 2; ++b)
#pragma unroll
            for (int m = 0; m < 4; ++m)
#pragma unroll
                for (int n = 0; n < 2; ++n) acc[a][b][m][n] = (f32x4){0.f, 0.f, 0.f, 0.f};
    bf16x8 At[4][2], B0[2][2], B1[2][2]; v8i At8[4], B08[2], B18[2];
    unsigned oc0[2], oc1[2], on0[2], on1[2];
    int sl = 0;
    if constexpr (P::GATHER) { if (wid == 0) { p.tok_issue(cur, 0, lane); Unit u1; if (p.next(1, u1)) p.tok_issue(u1, 1, lane); }
        asm volatile("s_waitcnt vmcnt(0)" ::: "memory"); __builtin_amdgcn_s_barrier(); asm volatile("" ::: "memory"); }
    p.aoff(cur, 0, R, C, oc0, oc1);
    const char* cA = cur.A; const char* cB = cur.B;
    G8_STAGE(G8_SB(0, 0), cB, voffB); G8_STAGE(G8_SB(0, 1), cB + hstepB, voffB); G8_STAGE(G8_SA(0, 0), cA, oc0); G8_STAGE(G8_SA(0, 1), cA, oc1);
    if (wr == 1) G8_BAR;
    G8_WAIT_V(2); G8_BAR;
    G8_STAGE(G8_SB(1, 0), cB + kstep, voffB); G8_STAGE(G8_SA(1, 0), cA + kstep, oc0); G8_STAGE(G8_SB(1, 1), cB + hstepB + kstep, voffB);
    G8_WAIT_V(6); G8_BAR;
    for (;;) {
        const bool has_next = p.next(ui + 1, nxt);
        const int sl1 = sl == 2 ? 0 : sl + 1, sl2 = sl1 == 2 ? 0 : sl1 + 1;
        if (wid == 0) { const int ln2 = fresh_lane();
            p.vec_issue(cur, ui & 1, ln2); if constexpr (P::GATHER) { Unit u2; if (p.next(ui + 2, u2)) p.tok_issue(u2, sl2, ln2); } }
        if (has_next) p.aoff(nxt, sl1, R, C, on0, on1); else { on0[0] = oc0[0]; on0[1] = oc0[1]; on1[0] = oc1[0]; on1[1] = oc1[1]; }
        const char* nA = has_next ? nxt.A : cA; const char* nB = has_next ? nxt.B : cB;
#define G8_KITER(t, MMAF, WAITF) do { \
            const bool last = ((t) == nt - 2); \
            const char* a1 = cA + (size_t)((t) + 1) * kstep; \
            const char* a2 = last ? nA : cA + (size_t)((t) + 2) * kstep; const char* b2 = last ? nB : cB + (size_t)((t) + 2) * kstep; \
            const char* a3 = a2 + kstep; const char* b3 = b2 + kstep; \
            unsigned o20[2], o21[2]; \
            o20[0] = last ? on0[0] : oc0[0]; o20[1] = last ? on0[1] : oc0[1]; o21[0] = last ? on1[0] : oc1[0]; o21[1] = last ? on1[1] : oc1[1]; \
              \
            G8_LDB(B0, 0, 0); G8_LDB(B1, 0, 1); G8_SCHED; G8_LDA(At, 0, 0); G8_STAGE(G8_SA(1, 1), a1, oc1); \
            WAITF; G8_WAIT_L(0); G8_BAR; MMAF(0, 0, At, B0); MMAF(0, 1, At, B1); G8_BAR; G8_SCHED; \
              \
            G8_LDA(At, 0, 1); G8_STAGE(G8_SB(0, 0), b2, voffB); G8_STAGE(G8_SB(0, 1), b2 + hstepB, voffB); G8_STAGE(G8_SA(0, 0), a2, o20); \
            WAITF; G8_WAIT_L(0); G8_BAR; MMAF(1, 0, At, B0); MMAF(1, 1, At, B1); G8_BAR; G8_SCHED; \
              \
            G8_LDB(B0, 1, 0); G8_LDB(B1, 1, 1); G8_SCHED; G8_LDA(At, 1, 0); G8_STAGE(G8_SA(0, 1), a2, o21); \
            G8_WAIT_V(8); G8_WAIT_L(0); G8_BAR; G8_MMA(0, 0, At, B0); G8_MMA(0, 1, At, B1); G8_BAR; G8_SCHED; \
              \
            G8_LDA(At, 1, 1); G8_STAGE(G8_SB(1, 0), b3, voffB); G8_STAGE(G8_SB(1, 1), b3 + hstepB, voffB); G8_STAGE(G8_SA(1, 0), a3, o20); \
            G8_WAIT_V(8); G8_WAIT_L(0); G8_BAR; G8_MMA(1, 0, At, B0); G8_MMA(1, 1, At, B1); G8_BAR; G8_SCHED; } while (0)
        if constexpr (P::FP8) {
            const bool after_epi = ui > 0;
            G8_KITER(0, G8_MMA0, G8_WAIT_VE(after_epi));
#pragma unroll 1
            for (int t = 2; t < nt; t += 2) G8_KITER(t, G8_MMA, G8_WAIT_V(8));
        } else {
#pragma unroll 1
            for (int t = 0; t < nt; t += 2) G8_KITER(t, G8_MMA, G8_WAIT_V(8));
        }
#undef G8_KITER
        if (wr == 0) G8_BAR;
        if constexpr (PROBE == 0) p.epi(acc, cur, ui & 1, wr, wc, fr, fq);
        else { float t = 0.f; _Pragma("unroll") for (int a = 0; a < 2; ++a) _Pragma("unroll") for (int b = 0; b < 2; ++b) _Pragma("unroll") for (int m = 0; m < 4; ++m) _Pragma("unroll") for (int n = 0; n < 2; ++n) t += acc[a][b][m][n].x + acc[a][b][m][n].y + acc[a][b][m][n].z + acc[a][b][m][n].w;
            if (t == 123.456f) ((float*)p.probe_sink())[0] = t; }
        if (!has_next) break;
        if constexpr (!P::FP8) {
#pragma unroll
        for (int a = 0; a < 2; ++a)
#pragma unroll
            for (int b = 0; b < 2; ++b)
#pragma unroll
                for (int m = 0; m < 4; ++m)
#pragma unroll
                    for (int n = 0; n < 2; ++n) acc[a][b][m][n] = (f32x4){0.f, 0.f, 0.f, 0.f};
        }
        cur = nxt; cA = nA; cB = nB; ++ui; sl = sl1;
        oc0[0] = on0[0]; oc0[1] = on0[1]; oc1[0] = on1[0]; oc1[1] = on1[1];
        if (wr == 1) G8_BAR;
    }
    G8_WAIT_V(0);
    G8_BAR;
#undef G8_SA
#undef G8_SB
#undef G8_STAGE
#undef G8_LDA
#undef G8_LDB
#undef G8_RD16
#undef G8_MMA
#undef G8_WAIT_V
#undef G8_WAIT_VE
#undef G8_WAIT_L
#undef G8_BAR
#undef G8_SCHED
}
}

struct Args { const float* in[33]; float* out; unsigned char* ws; int ph_lo, ph_hi; };
enum { I_X = 0, I_C, I_CTX, I_CCTX, I_WADA, I_BADA, I_GMIX, I_GFFN, I_ARE, I_AIM, I_LOGDT, I_BRE, I_BIM, I_CRE, I_CIM, I_SD, I_WGLU, I_BGLU,
       I_WQKV, I_WO, I_QGAIN, I_KGAIN, I_LQ1, I_LK1, I_LQ2, I_LK2, I_SUBG, I_WR, I_BR, I_WGU, I_BGU, I_WDN, I_BDN };
struct Ctx {
    const float* const* in; float* out; unsigned char* ws; ldsp lds;
    int tid, lane, wave, blk, G;
};
__device__ __forceinline__ const float* modp(const Ctx& F, int layer, int row) { return (const float*)(F.ws + WS_MOD) + ((size_t)layer * 17 + row) * 6144; }
__device__ __forceinline__ const float* in_row(const Ctx& F, int r) {
    const int b = r / SB, s = r - b * SB;
    return s < CTXL ? F.in[I_CTX] + ((size_t)b * CTXL + s) * DM : F.in[I_X] + ((size_t)b * LSEQ + (s - CTXL)) * DM;
}

__device__ __forceinline__ int rowmap_glu(int n) { const int half = n >> 10, c = n & 1023; return 256 * (c >> 7) + 128 * half + (c & 127); }
__device__ __forceinline__ int rowmap_gu(int n) { const int half = n >> 10, c = n & 1023, w = c & 127; return 256 * (c >> 7) + 128 * half + (w & ~31) + g8::slot_of_col32(w & 31); }
__device__ __forceinline__ int rowmap_dn(int n) { return (n & ~31) + g8::slot_of_col32(n & 31); }
__device__ __forceinline__ int rowmap_qkv(int n) {
    if (n >= 2048) return n;
    const int tile = n >> 8, t = n & 255, wc = t >> 6, i = t & 63, bj = i >> 5;
    return 256 * tile + 128 * bj + 32 * wc + g8::slot_of_col32(i & 31);
}
__device__ __forceinline__ unsigned pk4_fp8(float a, float b, float c, float d) { int w = 0; w = __builtin_amdgcn_cvt_pk_fp8_f32(a, b, w, false); w = __builtin_amdgcn_cvt_pk_fp8_f32(c, d, w, true); return (unsigned)w; }
typedef short s16x2 __attribute__((ext_vector_type(2)));
__device__ __forceinline__ int pk4_fp8_d16(float a, float b, float c, float d) { s16x2 w; asm volatile("" : "=v"(w));
    w = __builtin_amdgcn_cvt_scalef32_pk_fp8_f32(w, a, b, 16.0f, false); w = __builtin_amdgcn_cvt_scalef32_pk_fp8_f32(w, c, d, 16.0f, true); return __builtin_bit_cast(int, w); }
template <int MAP, bool FP8>
__device__ __forceinline__ void transpose_item(const float* W, int N, unsigned char* WT, LAS unsigned* scr, int item, int lane, float scale) {
    const int nblk = N / 64, kb = item / nblk, nb = item % nblk, k0 = 64 * kb, n0 = 64 * nb, q = lane >> 4, L = lane & 15;
    f32x4 v[16];
#pragma unroll
    for (int i = 0; i < 16; ++i) { const int row = FP8 ? 16 * (i >> 2) + 4 * q + (i & 3) : 8 * (i >> 1) + 2 * q + (i & 1); v[i] = __builtin_nontemporal_load((const f32x4*)(W + (size_t)(k0 + row) * N + n0 + 4 * L)); }
    if (FP8) {
#pragma unroll
        for (int j = 0; j < 4; ++j)
#pragma unroll
            for (int x = 0; x < 4; ++x) scr[(4 * L + x) * 17 + 4 * j + q] = pk4_fp8(v[4 * j][x] * scale, v[4 * j + 1][x] * scale, v[4 * j + 2][x] * scale, v[4 * j + 3][x] * scale);
    } else {
#pragma unroll
        for (int j = 0; j < 8; ++j)
#pragma unroll
            for (int x = 0; x < 4; ++x) scr[(4 * L + x) * 33 + 4 * j + q] = pkbf(v[2 * j][x], v[2 * j + 1][x]);
    }
    LDS_WAIT(); asm volatile("" ::: "memory");
    if (FP8) {
#pragma unroll
        for (int i = 0; i < 4; ++i) { const int n = 16 * i + (lane >> 2), c = lane & 3; const LAS unsigned* sp = scr + n * 17 + 4 * c;
            const u32x4 o = {sp[0], sp[1], sp[2], sp[3]}; const int nn = n0 + n;
            const int row = MAP == 0 ? nn : MAP == 2 ? rowmap_qkv(nn) : MAP == 3 ? rowmap_gu(nn) : rowmap_dn(nn);
            *(u32x4*)(WT + (size_t)row * 1024 + k0 + 16 * c) = o; }
    } else {
#pragma unroll
        for (int i = 0; i < 8; ++i) { const int n = 8 * i + (lane >> 3), c = lane & 7; const LAS unsigned* sp = scr + n * 33 + 4 * c;
            const u32x4 o = {sp[0], sp[1], sp[2], sp[3]}; const int nn = n0 + n;
            const int row = MAP == 0 ? nn : MAP == 2 ? rowmap_qkv(nn) : MAP == 3 ? rowmap_gu(nn) : rowmap_dn(nn);
            *(u32x4*)(WT + (size_t)row * 2048 + (k0 + 8 * c) * 2) = o; }
    }
    LDS_WAIT(); asm volatile("" ::: "memory");
}

__device__ __forceinline__ void sincos_d(double x, double& s, double& c) {
    const double TWO_PI = 6.283185307179586476925; const double k = __builtin_rint(x / TWO_PI); double r = x - k * TWO_PI;
    r *= 0.125;
    const double r2 = r * r;
    double sn = r * (1.0 + r2 * (-1.0 / 6 + r2 * (1.0 / 120 + r2 * (-1.0 / 5040 + r2 * (1.0 / 362880 + r2 * (-1.0 / 39916800 + r2 * (1.0 / 6227020800.0)))))));
    double cs = 1.0 + r2 * (-0.5 + r2 * (1.0 / 24 + r2 * (-1.0 / 720 + r2 * (1.0 / 40320 + r2 * (-1.0 / 3628800 + r2 * (1.0 / 479001600.0 + r2 * (-1.0 / 87178291200.0)))))));
#pragma unroll
    for (int i = 0; i < 3; ++i) { const double s2 = 2.0 * sn * cs, c2 = cs * cs - sn * sn; sn = s2; cs = c2; }
    s = sn; c = cs;
}
__device__ __forceinline__ double exp_small_d(double x) {
    return 1.0 + x * (1.0 + x * (0.5 + x * (1.0 / 6 + x * (1.0 / 24 + x * (1.0 / 120 + x * (1.0 / 720 + x * (1.0 / 5040 + x * (1.0 / 40320 + x * (1.0 / 362880 + x * (1.0 / 3628800))))))))));
}

__device__ __forceinline__ void s5_prep_group(const Ctx& F, int g) {
    LAS float* lpw = (LAS float*)(F.lds);
    LAS float* bb  = (LAS float*)(F.lds + 17408);
    LAS float* cc  = (LAS float*)(F.lds + 17408 + 16384);
    LAS float* kt  = (LAS float*)(F.lds + 17408 + 32768);
    const int t = F.tid;
    if (t < 128) {
        const int d = t >> 6, p = t & 63; const size_t gp = ((size_t)d * 64 + g) * 64 + p;
        const double are = F.in[I_ARE][gp], aim = F.in[I_AIM][gp];
        const double dt = exp((double)F.in[I_LOGDT][d * 64 + g]);
        const double lr = are * dt, li = aim * dt;
        double sn, cs; sincos_d(li, sn, cs);
        const double mag = exp_small_d(lr);
        const double lamr = mag * cs, lami = mag * sn;
        const double nr = lamr - 1.0, ni = lami, den = are * are + aim * aim;
        const double zr = (nr * are + ni * aim) / den, zi = (ni * are - nr * aim) / den;
        double pr = 1.0, pi = 0.0;
#pragma unroll 1
        for (int k = 0; k <= 16; ++k) { lpw[((d * 64 + p) * 17 + k) * 2] = (float)pr; lpw[((d * 64 + p) * 17 + k) * 2 + 1] = (float)pi;
            const double qr = pr * lamr - pi * lami, qi = pr * lami + pi * lamr; pr = qr; pi = qi; }
        float* lamt = (float*)(F.ws + WS_LAMT) + (((size_t)g * 2 + d) * 64 + p) * 2;
        lamt[0] = lpw[((d * 64 + p) * 17 + 16) * 2]; lamt[1] = lpw[((d * 64 + p) * 17 + 16) * 2 + 1];
#pragma unroll
        for (int c = 0; c < 16; ++c) { const size_t bi = (((size_t)d * 64 + g) * 64 + p) * 16 + c; const double br = F.in[I_BRE][bi], bim = F.in[I_BIM][bi];
            bb[((d * 64 + p) * 16 + c) * 2] = (float)(zr * br - zi * bim); bb[((d * 64 + p) * 16 + c) * 2 + 1] = (float)(zr * bim + zi * br); }
    }
#pragma unroll
    for (int i = t; i < 2048; i += 512) { const int d = i >> 10, c = (i >> 6) & 15, p = i & 63; const size_t ci = (((size_t)d * 64 + g) * 16 + c) * 64 + p;
        cc[i * 2] = F.in[I_CRE][ci]; cc[i * 2 + 1] = F.in[I_CIM][ci]; }
    __syncthreads();
    {
        const int d = t >> 8, c = (t >> 4) & 15, c2 = t & 15;
        float kacc[16];
#pragma unroll
        for (int k = 0; k < 16; ++k) kacc[k] = 0.f;
#pragma unroll 1
        for (int p = 0; p < 64; ++p) {
            const float cr = cc[((d * 16 + c) * 64 + p) * 2], ci = cc[((d * 16 + c) * 64 + p) * 2 + 1];
            const float br = bb[((d * 64 + p) * 16 + c2) * 2], bi = bb[((d * 64 + p) * 16 + c2) * 2 + 1];
            const float lr = lpw[((d * 64 + p) * 17 + 1) * 2], li = lpw[((d * 64 + p) * 17 + 1) * 2 + 1];
            float wr = cr * br - ci * bi, wi = cr * bi + ci * br;
#pragma unroll
            for (int k = 0; k < 16; ++k) { kacc[k] += wr; const float nr = wr * lr - wi * li, ni = wr * li + wi * lr; wr = nr; wi = ni; }
        }
#pragma unroll
        for (int k = 0; k < 16; ++k) kt[(d * 16 + k) * 256 + c * 16 + c2] = kacc[k];
    }
    __syncthreads();
    bf16* acat = (bf16*)(F.ws + WS_ACAT) + (size_t)g * 256 * 512;
    const float* dsk = F.in[I_SD] + g * 16;
#pragma unroll 1
    for (int it = 0; it < 32; ++it) {
        const int idx = t + 512 * it, rho = idx >> 6, k0 = (idx & 63) * 8;
        const int N = (rho & ~31) + g8::col_of_slot32(rho & 31), j = N >> 4, c = N & 15;
        float v[8];
        if (k0 < 256) {
            const int i = k0 >> 4, c0 = k0 & 15;
#pragma unroll
            for (int q = 0; q < 8; ++q) { const int c2 = c0 + q;
                v[q] = j > i ? kt[(0 * 16 + (j - i)) * 256 + c * 16 + c2] : j < i ? kt[(1 * 16 + (i - j)) * 256 + c * 16 + c2]
                     : kt[c * 16 + c2] + kt[16 * 256 + c * 16 + c2] + (c == c2 ? dsk[c] : 0.f); }
        } else {
            const int d = k0 >= 384 ? 1 : 0, q0 = k0 - 256 - 128 * d, pw = d ? 16 - j : j + 1;
#pragma unroll
            for (int q = 0; q < 4; ++q) { const int p = (q0 >> 1) + q;
                const float cr = cc[((d * 16 + c) * 64 + p) * 2], ci = cc[((d * 16 + c) * 64 + p) * 2 + 1];
                const float lr = lpw[((d * 64 + p) * 17 + pw) * 2], li = lpw[((d * 64 + p) * 17 + pw) * 2 + 1];
                v[2 * q] = cr * lr - ci * li; v[2 * q + 1] = -(cr * li + ci * lr); }
        }
        u32x4 o; o.x = pk2(v[0], v[1]); o.y = pk2(v[2], v[3]); o.z = pk2(v[4], v[5]); o.w = pk2(v[6], v[7]);
        *(u32x4*)(acat + (size_t)rho * 512 + k0) = o;
    }
    bf16* fmat = (bf16*)(F.ws + WS_FMAT) + (size_t)g * 256 * 256;
#pragma unroll 1
    for (int it = 0; it < 16; ++it) {
        const int idx = t + 512 * it, n = idx >> 5, k0 = (idx & 31) * 8;
        const int d = n >> 7, p = (n & 127) >> 1, im = n & 1, i = k0 >> 4, c0 = k0 & 15, pw = d ? i : 15 - i;
        const float lr = lpw[((d * 64 + p) * 17 + pw) * 2], li = lpw[((d * 64 + p) * 17 + pw) * 2 + 1];
        float v[8];
#pragma unroll
        for (int q = 0; q < 8; ++q) { const float br = bb[((d * 64 + p) * 16 + c0 + q) * 2], bi = bb[((d * 64 + p) * 16 + c0 + q) * 2 + 1];
            v[q] = im ? lr * bi + li * br : lr * br - li * bi; }
        u32x4 o; o.x = pk2(v[0], v[1]); o.y = pk2(v[2], v[3]); o.z = pk2(v[4], v[5]); o.w = pk2(v[6], v[7]);
        *(u32x4*)(fmat + (size_t)n * 256 + k0) = o;
    }
    __syncthreads();
}

__device__ __forceinline__ void adaln_item(const Ctx& F, int item) {
    LAS float* sil = (LAS float*)(F.lds);
    LAS float* red = (LAS float*)(F.lds + 17 * 1024 * 4);
    { f32x4 t[9];
#pragma unroll
      for (int q = 0; q < 9; ++q) { const int i4 = F.tid + 512 * q; t[q] = i4 < 16 * 256 ? ((const f32x4*)F.in[I_C])[i4] : i4 < 17 * 256 ? ((const f32x4*)F.in[I_CCTX])[i4 - 16 * 256] : (f32x4){0.f, 0.f, 0.f, 0.f}; }
#pragma unroll
      for (int q = 0; q < 9; ++q) { const int i4 = F.tid + 512 * q; if (i4 < 17 * 256) ((LAS f32x4*)sil)[i4] = (f32x4){silu_f(t[q].x), silu_f(t[q].y), silu_f(t[q].z), silu_f(t[q].w)}; } }
    __syncthreads();
    const int li = item / 96, cb = item % 96, n = cb * 64 + F.lane;
    const float* W = F.in[I_WADA] + (size_t)li * 1024 * 6144 + n;
    float acc[17];
#pragma unroll
    for (int r = 0; r < 17; ++r) acc[r] = 0.f;
    const int kbeg = F.wave * 128;
#pragma unroll 8
    for (int k = kbeg; k < kbeg + 128; k += 4) {
        const float w0 = __builtin_nontemporal_load(W + (size_t)k * 6144), w1 = __builtin_nontemporal_load(W + (size_t)(k + 1) * 6144), w2 = __builtin_nontemporal_load(W + (size_t)(k + 2) * 6144), w3 = __builtin_nontemporal_load(W + (size_t)(k + 3) * 6144);
#pragma unroll
        for (int r = 0; r < 17; ++r) { const f32x4 s = *(const LAS f32x4*)(sil + r * 1024 + k); acc[r] += s.x * w0 + s.y * w1 + s.z * w2 + s.w * w3; }
    }
#pragma unroll
    for (int r = 0; r < 17; ++r) red[(F.wave * 17 + r) * 64 + F.lane] = acc[r];
    __syncthreads();
    for (int i = F.tid; i < 17 * 64; i += 512) { const int r = i >> 6, l = i & 63; float s = F.in[I_BADA][li * 6144 + cb * 64 + l];
#pragma unroll
        for (int w = 0; w < 8; ++w) s += red[(w * 17 + r) * 64 + l];
        ((float*)(F.ws + WS_MOD))[((size_t)li * 17 + r) * 6144 + cb * 64 + l] = s; }
    __syncthreads();
}

constexpr int TI_GLU = 16 * 32, TI_QKV = 16 * 48, TI_O = 16 * 16, TI_GU1 = 16 * 32, TI_DN1 = 16 * 16;
__device__ __forceinline__ void p0_prep(const Ctx& F) {
    for (int it = F.blk; it < 256; it += F.G) { if (it < 192) adaln_item(F, it); else s5_prep_group(F, it - 192); }
    LAS unsigned* scr = (LAS unsigned*)(F.lds + F.wave * 8448);
    const int gw = F.blk * 8 + F.wave, NGW = F.G * 8;
    for (int it = gw; it < TI_GLU + TI_QKV + TI_O; it += NGW) {
        int r = it;
        if (r < TI_GLU) { transpose_item<3, true>(F.in[I_WGLU], 2048, F.ws + WS_WGLU, scr, r, F.lane, W8_SCALE); continue; } r -= TI_GLU;
        if (r < TI_QKV) { transpose_item<2, true>(F.in[I_WQKV], 3072, F.ws + WS_WQKV, scr, r, F.lane, W8_SCALE); continue; } r -= TI_QKV;
        transpose_item<4, true>(F.in[I_WO], 1024, F.ws + WS_WO, scr, r, F.lane, W8_SCALE);
    }
}
struct TrItem { const float* W; unsigned char* WT; int N, k0, n0, dn; };
__device__ __forceinline__ TrItem tr_decode(const Ctx& F, int it) {
    TrItem t; int r = it;
    if (r < 64 * TI_GU1) { const int le = r / TI_GU1, item = r - le * TI_GU1; t.W = F.in[I_WGU] + (size_t)le * 1024 * 2048; t.WT = F.ws + WS_WGU + (size_t)le * 2048 * 1024; t.N = 2048; t.dn = 0; t.k0 = 64 * (item >> 5); t.n0 = 64 * (item & 31); }
    else { r -= 64 * TI_GU1; const int le = r / TI_DN1, item = r - le * TI_DN1; t.W = F.in[I_WDN] + (size_t)le * 1024 * 1024; t.WT = F.ws + WS_WDN + (size_t)le * 1024 * 1024; t.N = 1024; t.dn = 1; t.k0 = 64 * (item >> 4); t.n0 = 64 * (item & 15); }
    return t;
}
__device__ __forceinline__ void tr_load(const TrItem& t, int lane, f32x4 (&v)[16]) {
    const int q = lane >> 4, L = lane & 15;
#pragma unroll
    for (int i = 0; i < 16; ++i) { const int row = 16 * (i >> 2) + 4 * q + (i & 3); v[i] = __builtin_nontemporal_load((const f32x4*)(t.W + (size_t)(t.k0 + row) * t.N + t.n0 + 4 * L)); }
}
__device__ __forceinline__ void tr_finish(const TrItem& t, int lane, const f32x4 (&v)[16], LAS unsigned* scr) {
    const int q = lane >> 4, L = lane & 15;
#pragma unroll
    for (int j = 0; j < 4; ++j)
#pragma unroll
        for (int x = 0; x < 4; ++x) scr[(4 * L + x) * 17 + 4 * j + q] = pk4_fp8(v[4 * j][x] * W8_SCALE, v[4 * j + 1][x] * W8_SCALE, v[4 * j + 2][x] * W8_SCALE, v[4 * j + 3][x] * W8_SCALE);
    LDS_WAIT(); asm volatile("" ::: "memory");
#pragma unroll
    for (int i = 0; i < 4; ++i) { const int n = 16 * i + (lane >> 2), c = lane & 3; const LAS unsigned* sp = scr + n * 17 + 4 * c;
        const u32x4 o = {sp[0], sp[1], sp[2], sp[3]}; const int nn = t.n0 + n; const int row = t.dn ? rowmap_dn(nn) : rowmap_gu(nn);
        __builtin_nontemporal_store(o, (u32x4*)(t.WT + (size_t)row * 1024 + t.k0 + 16 * c)); }
    LDS_WAIT(); asm volatile("" ::: "memory");
}
__device__ __forceinline__ void p0_moe_weights(const Ctx& F, int vb, int nvb) {
    LAS unsigned* scr = (LAS unsigned*)(F.lds + F.wave * 8448);
    const int gw = vb * 8 + F.wave, NGW = nvb * 8; constexpr int NIT = 64 * (TI_GU1 + TI_DN1);
    int it = gw; if (it >= NIT) return;
    TrItem cur = tr_decode(F, it); f32x4 va[16], vn[16];
    tr_load(cur, F.lane, va);
#pragma unroll 1
    for (;;) {
        const int nx = it + NGW; const bool has = nx < NIT; TrItem nxt = cur;
        if (has) { nxt = tr_decode(F, nx); tr_load(nxt, F.lane, vn); }
        tr_finish(cur, F.lane, va, scr);
        if (!has) break;
        it = nx; cur = nxt;
#pragma unroll
        for (int i = 0; i < 16; ++i) va[i] = vn[i];
    }
}

__device__ __forceinline__ void p1_norm0(const Ctx& F) {
    const int gw = F.blk * 8 + F.wave, NGW = F.G * 8;
    bf16* bcat = (bf16*)(F.ws + WS_BCAT);
    LAS u32x4* tab = (LAS u32x4*)F.lds;
    __syncthreads();
    for (int idx = F.tid; idx < 17 * 256; idx += 512) { const int var = idx >> 8, j = (idx >> 6) & 3, ln = idx & 63, c0 = ln * 16 + 4 * j;
        const float* mod = modp(F, 0, var);
        const f32x4 h = *(const f32x4*)(mod + c0), c = *(const f32x4*)(mod + 1024 + c0), g = *(const f32x4*)(F.in[I_GMIX] + c0);
        const f32x4 a = g * (1.f + c);
        tab[idx] = (u32x4){pkbf(a.x, h.x), pkbf(a.y, h.y), pkbf(a.z, h.z), pkbf(a.w, h.w)}; }
    __syncthreads();
#define P1_LOAD(r, X) do { const f32x4* _s = (const f32x4*)(in_row(F, r) + F.lane * 16); _Pragma("unroll") for (int j = 0; j < 4; ++j) X[j] = _s[j]; } while (0)
#define P1_ROW(rr, X) do { const int _r = (rr), _b = _r / SB, _s = _r - _b * SB; float _ss = 0.f; \
        _Pragma("unroll") for (int j = 0; j < 4; ++j) _ss += (X[j].x * X[j].x + X[j].y * X[j].y) + (X[j].z * X[j].z + X[j].w * X[j].w); \
        const float _rstd = rsqrtf(wave_sum(_ss) * (1.f / DM) + NORM_EPS); \
        const LAS u32x4* _trow = tab + (_s < CTXL ? 16 : _b) * 256 + F.lane; unsigned _w[8]; \
        _Pragma("unroll") for (int j = 0; j < 4; ++j) { const u32x4 _t = _trow[64 * j]; \
            const float a0 = X[j].x * _rstd * bf_lo(_t.x) + bf_hi(_t.x), a1 = X[j].y * _rstd * bf_lo(_t.y) + bf_hi(_t.y), a2 = X[j].z * _rstd * bf_lo(_t.z) + bf_hi(_t.z), a3 = X[j].w * _rstd * bf_lo(_t.w) + bf_hi(_t.w); \
            _w[2 * j] = pkbf(a0, a1); _w[2 * j + 1] = pkbf(a2, a3); } \
        u32x4* _dst = (u32x4*)(bcat + (((size_t)F.lane * (NB * NCHUNK) + _b * NCHUNK + (_s >> 4)) * 512 + (_s & 15) * 16)); \
        _dst[0] = (u32x4){_w[0], _w[1], _w[2], _w[3]}; _dst[1] = (u32x4){_w[4], _w[5], _w[6], _w[7]}; } while (0)
    const int KP = (NROW / NGW) & ~1;
    f32x4 xa0[4], xa1[4], xb0[4], xb1[4];
    if (KP >= 2) {
        P1_LOAD(gw, xa0); P1_LOAD(gw + NGW, xa1);
        int k = 0;
#pragma unroll 1
        for (; k + 6 <= KP; k += 4) {
            const int r = gw + k * NGW;
            P1_LOAD(r + 2 * NGW, xb0); P1_LOAD(r + 3 * NGW, xb1);
            __builtin_amdgcn_sched_barrier(0);
            P1_ROW(r, xa0); P1_ROW(r + NGW, xa1);
            __builtin_amdgcn_sched_barrier(0);
            P1_LOAD(r + 4 * NGW, xa0); P1_LOAD(r + 5 * NGW, xa1);
            __builtin_amdgcn_sched_barrier(0);
            P1_ROW(r + 2 * NGW, xb0); P1_ROW(r + 3 * NGW, xb1);
            __builtin_amdgcn_sched_barrier(0);
        }
        {   const int r = gw + k * NGW;
            if (KP - k == 4) { P1_LOAD(r + 2 * NGW, xb0); P1_LOAD(r + 3 * NGW, xb1); }
            P1_ROW(r, xa0); P1_ROW(r + NGW, xa1);
            if (KP - k == 4) { P1_ROW(r + 2 * NGW, xb0); P1_ROW(r + 3 * NGW, xb1); } }
    }
    for (int r = gw + KP * NGW; r < NROW; r += NGW) { P1_LOAD(r, xa0); P1_ROW(r, xa0); }
    __syncthreads();
#undef P1_LOAD
#undef P1_ROW
}

__device__ __forceinline__ void p3_carry(const Ctx& F) {
    for (int id = F.blk * 512 + F.tid; id < 64 * NB * 2 * 64; id += F.G * 512) {
        const int p = id & 63, d = (id >> 6) & 1, b = (id >> 7) & 15, g = id >> 11;
        const float* lamt = (const float*)(F.ws + WS_LAMT) + (((size_t)g * 2 + d) * 64 + p) * 2;
        const float lr = lamt[0], li = lamt[1];
        const float* S = (const float*)(F.ws + WS_SBUF) + ((size_t)g * (NB * NCHUNK) + b * NCHUNK) * 256 + d * 128 + 2 * p;
        unsigned* H = (unsigned*)((bf16*)(F.ws + WS_BCAT) + ((size_t)g * (NB * NCHUNK) + b * NCHUNK) * 512 + 256 + d * 128 + 2 * p);
        float hr = 0.f, hi = 0.f;
#pragma unroll 1
        for (int q0 = 0; q0 < NCHUNK; q0 += 8) {
            f32x2 sv[8];
#pragma unroll
            for (int u = 0; u < 8; ++u) { const int q = q0 + u, k = d == 0 ? q : (q < 16 ? 15 - q : 159 - q); sv[u] = __builtin_nontemporal_load((const f32x2*)(S + (size_t)k * 256)); }
#pragma unroll
            for (int u = 0; u < 8; ++u) { const int q = q0 + u, k = d == 0 ? q : (q < 16 ? 15 - q : 159 - q);
                H[(size_t)k * 256] = pkbf(hr, hi);
                const float nr = lr * hr - li * hi + sv[u].x, ni = lr * hi + li * hr + sv[u].y; hr = nr; hi = ni; }
        }
    }
}

__device__ __forceinline__ void load_prefix(const Ctx& F, int layer) {
    LAS int* pref = (LAS int*)(F.lds + MISC_OFF + MO_PREF); LAS int* cnt = (LAS int*)(F.lds + MISC_OFF + MO_CNT);
    __syncthreads();
    if (F.tid < 32) cnt[F.tid] = (int)__hip_atomic_load((unsigned*)(F.ws + WS_CTL) + CW_CNT + (layer * 32 + F.tid) * 64, __ATOMIC_RELAXED, __HIP_MEMORY_SCOPE_AGENT);
    __syncthreads();
    if (F.tid == 0) { int a = 0; for (int e = 0; e < 32; ++e) { pref[e] = a; a += (cnt[e] + 255) >> 8; } pref[32] = a; }
    __syncthreads();
    LAS u32x2* tile_rec = (LAS u32x2*)(F.lds + MISC_OFF + MO_SEL);
    for (int t = F.tid; t < MAXTILES; t += 512) { int e = 0;
        for (int q = 1; q < 32; ++q) e = (pref[q] <= t) ? q : e;
        const int ti = t - pref[e];
        tile_rec[t] = (u32x2){(unsigned)(e | (ti << 8)), (unsigned)(cnt[e] - ti * 256)}; }
    __syncthreads();
}

template <int LAYER>
__device__ __forceinline__ void p_router(const Ctx& F) {
    constexpr int TS = 1028;
    LAS float* ht = (LAS float*)F.lds;
    LAS float* part = (LAS float*)(F.lds + 66048);
    LAS float* lgs = (LAS float*)(F.lds + 66048 + 16384);
    LAS float* pick = lgs + 512;
    LAS int* hist = (LAS int*)(F.lds + MISC_OFF + MO_HIST); LAS int* base = (LAS int*)(F.lds + MISC_OFF + MO_BASE);
    LAS int* sel_e = (LAS int*)(F.lds + MISC_OFF + MO_SEL); LAS int* sel_p = sel_e + 576; LAS float* sel_g = (LAS float*)(sel_p + 576);
    const int kg = F.lane >> 4, l15 = F.lane & 15;
    bf16x8 whi[4][2], wlo[4][2];
    { const float* wr = F.in[I_WR] + (size_t)LAYER * 1024 * 32;
#pragma unroll
      for (int ks = 0; ks < 4; ++ks)
#pragma unroll
        for (int nb = 0; nb < 2; ++nb) { float w[8];
#pragma unroll
            for (int j = 0; j < 8; ++j) w[j] = wr[(size_t)(128 * F.wave + 32 * ks + 8 * kg + j) * 32 + nb * 16 + l15];
            u32x4 h, l;
            h.x = pkbf(w[0], w[1]); h.y = pkbf(w[2], w[3]); h.z = pkbf(w[4], w[5]); h.w = pkbf(w[6], w[7]);
            l.x = pkbf(w[0] - bf_lo(h.x), w[1] - bf_hi(h.x)); l.y = pkbf(w[2] - bf_lo(h.y), w[3] - bf_hi(h.y)); l.z = pkbf(w[4] - bf_lo(h.z), w[5] - bf_hi(h.z)); l.w = pkbf(w[6] - bf_lo(h.w), w[7] - bf_hi(h.w));
            whi[ks][nb] = __builtin_bit_cast(bf16x8, h); wlo[ks][nb] = __builtin_bit_cast(bf16x8, l); } }
    constexpr int NR = LAYER == 0 ? 144 : 128, NSTEP = NR / 16;
    constexpr int NITEM = LAYER == 0 ? NROW / 144 : NLAT / 128;
    unsigned char* h2 = F.ws + WS_HB;
    const float brv = F.in[I_BR][LAYER * 32 + (F.tid & 31)];
#define RT_ROW(i) (LAYER == 0 ? item * 144 + (i) : (((item * 128 + (i)) >> 11) * SB + CTXL + ((item * 128 + (i)) & 2047)))
#define RT_LOAD(r, X, Y) do { const XT* _s = (const XT*)(LAYER == 0 ? (const void*)in_row(F, r) : (const void*)((const bf16*)(F.ws + WS_XS2) + (size_t)(r) * DM)) + F.lane; \
        const unsigned* _y = (const unsigned*)(F.ws + (LAYER == 0 ? WS_YG0 : WS_YG1) + (size_t)(r) * DM) + F.lane; _Pragma("unroll") for (int j = 0; j < 4; ++j) { X[j] = _s[64 * j]; Y[j] = _y[64 * j]; } } while (0)
    LAS f32x4* mvr = (LAS f32x4*)(F.lds + 98304);
    for (int item = F.blk; item < NITEM; item += F.G) {
        if (F.tid < 32) hist[F.tid] = 0;
        if (F.tid < 256) { const int t = F.tid, bi = item >> 4;
#pragma unroll
            for (int v = 0; v < (LAYER == 0 ? 2 : 1); ++v) { const float* m = modp(F, LAYER, v ? 16 : bi);
                const f32x4 h = ((const f32x4*)(m + 3072))[t], c = ((const f32x4*)(m + 4096))[t], g = ((const f32x4*)(F.in[I_GFFN] + LAYER * 1024))[t];
                mvr[v * 512 + t] = g * (1.f + c); mvr[v * 512 + 256 + t] = h; } }
        typedef typename XRowT<LAYER>::T XT; XT xn[2][4]; unsigned yn[2][4];
        RT_LOAD(RT_ROW(2 * F.wave), xn[0], yn[0]); RT_LOAD(RT_ROW(2 * F.wave + 1), xn[1], yn[1]);
        __syncthreads();
#pragma unroll 1
        for (int st = 0; st < NSTEP; ++st) {
#pragma unroll
            for (int q = 0; q < 2; ++q) {
                const int i = st * 16 + 2 * F.wave + q, r = RT_ROW(i), b = r / SB, s = r - b * SB;
                f32x4 v[4];
#pragma unroll
                for (int j = 0; j < 4; ++j) { v[j] = x_wide(xn[q][j]); v[j].x += __builtin_amdgcn_cvt_f32_fp8(yn[q][j], 0); v[j].y += __builtin_amdgcn_cvt_f32_fp8(yn[q][j], 1); v[j].z += __builtin_amdgcn_cvt_f32_fp8(yn[q][j], 2); v[j].w += __builtin_amdgcn_cvt_f32_fp8(yn[q][j], 3); }
                if (st + 1 < NSTEP) { const int r1 = RT_ROW(i + 16); RT_LOAD(r1, xn[q], yn[q]); }
                if (LAYER == 0) {
                    u32x2* xd = (u32x2*)((bf16*)(F.ws + WS_XS1) + (size_t)r * DM) + F.lane;
#pragma unroll
                    for (int j = 0; j < 4; ++j) xd[64 * j] = (u32x2){pkbf(v[j].x, v[j].y), pkbf(v[j].z, v[j].w)}; }
                float ss = 0.f;
#pragma unroll
                for (int j = 0; j < 4; ++j) { ss += (v[j].x * v[j].x + v[j].y * v[j].y) + (v[j].z * v[j].z + v[j].w * v[j].w); }
                const float rstd = rsqrtf(wave_sum(ss) * (1.f / DM) + NORM_EPS);
                const LAS f32x4* mrow = mvr + ((LAYER == 0 && s < CTXL) ? 512 : 0) + F.lane;
                unsigned* dst = (unsigned*)(h2 + (size_t)r * DM) + F.lane;
                LAS f32x4* hrow = (LAS f32x4*)(ht + (2 * F.wave + q) * TS) + F.lane;
#pragma unroll
                for (int j = 0; j < 4; ++j) { const f32x4 g = mrow[64 * j] * rstd, h = mrow[256 + 64 * j];
                    v[j] = v[j] * g + h;
                    dst[64 * j] = pk4_fp8(v[j].x, v[j].y, v[j].z, v[j].w); hrow[64 * j] = v[j]; }
            }
            __syncthreads();
            { f32x4 acc0 = {0.f, 0.f, 0.f, 0.f}, acc1 = {0.f, 0.f, 0.f, 0.f};
#pragma unroll
              for (int ks = 0; ks < 4; ++ks) {
                const LAS f32x4* ap = (const LAS f32x4*)(ht + l15 * TS + 128 * F.wave + 32 * ks + 8 * kg);
                const f32x4 a0 = ap[0], a1 = ap[1];
                u32x4 h, l;
                h.x = pkbf(a0.x, a0.y); h.y = pkbf(a0.z, a0.w); h.z = pkbf(a1.x, a1.y); h.w = pkbf(a1.z, a1.w);
                l.x = pkbf(a0.x - bf_lo(h.x), a0.y - bf_hi(h.x)); l.y = pkbf(a0.z - bf_lo(h.y), a0.w - bf_hi(h.y)); l.z = pkbf(a1.x - bf_lo(h.z), a1.y - bf_hi(h.z)); l.w = pkbf(a1.z - bf_lo(h.w), a1.w - bf_hi(h.w));
                const bf16x8 ah = __builtin_bit_cast(bf16x8, h), al = __builtin_bit_cast(bf16x8, l);
                acc0 = __builtin_amdgcn_mfma_f32_16x16x32_bf16(ah, whi[ks][0], acc0, 0, 0, 0); acc0 = __builtin_amdgcn_mfma_f32_16x16x32_bf16(ah, wlo[ks][0], acc0, 0, 0, 0); acc0 = __builtin_amdgcn_mfma_f32_16x16x32_bf16(al, whi[ks][0], acc0, 0, 0, 0);
                acc1 = __builtin_amdgcn_mfma_f32_16x16x32_bf16(ah, whi[ks][1], acc1, 0, 0, 0); acc1 = __builtin_amdgcn_mfma_f32_16x16x32_bf16(ah, wlo[ks][1], acc1, 0, 0, 0); acc1 = __builtin_amdgcn_mfma_f32_16x16x32_bf16(al, whi[ks][1], acc1, 0, 0, 0);
              }
              LAS float* pw = part + F.wave * 512 + (4 * kg) * 32 + l15;
#pragma unroll
              for (int rr = 0; rr < 4; ++rr) { pw[rr * 32] = acc0[rr]; pw[rr * 32 + 16] = acc1[rr]; } }
            __syncthreads();
            { const int row = F.tid >> 5, e = F.tid & 31;
              float lg = brv;
#pragma unroll
              for (int w = 0; w < 8; ++w) lg += part[w * 512 + row * 32 + e];
              lgs[row * 32 + e] = lg;
              LDS_WAIT(); asm volatile("" ::: "memory");
              int rank = 0;
#pragma unroll
              for (int q = 0; q < 8; ++q) { const f32x4 o = *(const LAS f32x4*)(lgs + row * 32 + 4 * q);
                  rank += (int)((o.x > lg) | ((o.x == lg) & (4 * q + 0 < e))); rank += (int)((o.y > lg) | ((o.y == lg) & (4 * q + 1 < e)));
                  rank += (int)((o.z > lg) | ((o.z == lg) & (4 * q + 2 < e))); rank += (int)((o.w > lg) | ((o.w == lg) & (4 * q + 3 < e))); }
              asm volatile("" ::: "memory");
              if (rank < 4) { pick[(row * 4 + rank) * 2] = lg; ((LAS int*)pick)[(row * 4 + rank) * 2 + 1] = e; }
              LDS_WAIT(); asm volatile("" ::: "memory");
              if (e < 4) { const f32x4 t01 = *(const LAS f32x4*)(pick + row * 8), t23 = *(const LAS f32x4*)(pick + row * 8 + 4);
                  const float e1 = __expf(t01.z - t01.x), e2 = __expf(t23.x - t01.x), e3 = __expf(t23.z - t01.x), inv = 1.f / (1.f + e1 + e2 + e3);
                  const int ek = __builtin_bit_cast(int, e == 0 ? t01.y : e == 1 ? t01.w : e == 2 ? t23.y : t23.w);
                  const float gk = (e == 0 ? 1.f : e == 1 ? e1 : e == 2 ? e2 : e3) * inv;
                  const int lp = __hip_atomic_fetch_add(hist + ek, 1, __ATOMIC_RELAXED, __HIP_MEMORY_SCOPE_WORKGROUP);
                  const int i = st * 16 + row;
                  sel_e[i * 4 + e] = ek; sel_p[i * 4 + e] = lp; sel_g[i * 4 + e] = gk; } }
        }
        __syncthreads();
        if (F.tid < 32) base[F.tid] = (int)__hip_atomic_fetch_add((unsigned*)(F.ws + WS_CTL) + CW_CNT + (LAYER * 32 + F.tid) * 64, (unsigned)hist[F.tid], __ATOMIC_RELAXED, __HIP_MEMORY_SCOPE_AGENT);
        __syncthreads();
        for (int idx = F.tid; idx < NR * 4; idx += 512) { const int i = idx >> 2, r = RT_ROW(i);
            const int e = sel_e[idx], pos = base[e] + sel_p[idx];
            ((int*)(F.ws + WS_ROUTE_E))[(size_t)r * 4 + (idx & 3)] = e; ((int*)(F.ws + WS_ROUTE_P))[(size_t)r * 4 + (idx & 3)] = pos; ((float*)(F.ws + WS_ROUTE_G))[(size_t)r * 4 + (idx & 3)] = sel_g[idx];
            ((int*)(F.ws + WS_TOKL))[(size_t)e * NROW + pos] = r; }
        __syncthreads();
    }
#undef RT_ROW
#undef RT_LOAD
}

template <int LAYER>
__device__ __forceinline__ void p_combine(const Ctx& F) {
    load_prefix(F, LAYER);
    const LAS int* pref = (const LAS int*)(F.lds + MISC_OFF + MO_PREF);
    const unsigned char* ys = F.ws + WS_YS;
    const int* re = (const int*)(F.ws + WS_ROUTE_E); const int* rp = (const int*)(F.ws + WS_ROUTE_P); const float* rg = (const float*)(F.ws + WS_ROUTE_G);
    constexpr int NTOT = LAYER == 0 ? NROW : NLAT, RPB = NTOT / 256, NSTEP = RPB / 8;
    LAS f32x4* mv = (LAS f32x4*)F.lds; LAS i32x4* rkL = (LAS i32x4*)(F.lds + 32768); LAS f32x4* gL = (LAS f32x4*)(F.lds + 36864);
#define CMB_ROW(n) (LAYER == 0 ? (n) : ((n) >> 11) * SB + CTXL + ((n) & 2047))
#define CMB_RK(li, RK, GK) do { const i32x4 _r = rkL[li]; const i32x4 _q = ((LAS i32x4*)gL)[li]; _Pragma("unroll") for (int k = 0; k < 4; ++k) { RK[k] = __builtin_amdgcn_readfirstlane(_r[k]); \
        GK[k] = __builtin_bit_cast(float, __builtin_amdgcn_readfirstlane(_q[k])); } } while (0)
#define CMB_LOAD(r, RK, X, Y, G) do { const u32x2* _s = (const u32x2*)((const bf16*)(F.ws + (LAYER == 0 ? WS_XS1 : WS_XS2)) + (size_t)(r) * DM) + F.lane; \
        const unsigned* _g = (const unsigned*)(F.ws + WS_YG1 + (size_t)(r) * DM) + F.lane; _Pragma("unroll") for (int j = 0; j < 4; ++j) { X[j] = __builtin_nontemporal_load(_s + 64 * j); if (LAYER == 1) G[j] = __builtin_nontemporal_load(_g + 64 * j); \
        _Pragma("unroll") for (int k = 0; k < 4; ++k) Y[k][j] = __builtin_nontemporal_load((const unsigned*)(ys + (size_t)RK[k] * DM) + F.lane + 64 * j); } } while (0)
    for (int item = F.blk; item < 256; item += F.G) {
        const int nbase = item * RPB + F.wave, b = item >> 4;
        __syncthreads();
        {   const int rb = CMB_ROW(item * RPB);
            for (int t = F.tid; t < RPB * 4; t += 512) { const size_t q = (size_t)rb * 4 + t; ((LAS int*)rkL)[t] = pref[re[q]] * 256 + rp[q]; ((LAS float*)gL)[t] = rg[q]; } }
        if (F.tid < 256) { const int t = F.tid;
            if (LAYER == 0) {
#pragma unroll
                for (int v = 0; v < 2; ++v) { const float* m0 = modp(F, 0, v ? 16 : b); const float* m1 = modp(F, 1, v ? 16 : b);
                    const f32x4 gt = ((const f32x4*)(m0 + 5120))[t], sh = ((const f32x4*)m1)[t], sc = ((const f32x4*)(m1 + 1024))[t], gg = ((const f32x4*)(F.in[I_GMIX] + 1024))[t];
                    mv[v * 768 + t] = gt; mv[v * 768 + 256 + t] = gg * (1.f + sc); mv[v * 768 + 512 + t] = sh; }
            } else mv[t] = ((const f32x4*)(modp(F, 1, b) + 5120))[t];
        }
        __syncthreads();
        u32x2 xa[4], xb[4]; unsigned ya[4][4], yb[4][4]; unsigned ga[4], gb[4];
        float gkA[4], gkB[4]; int rk[4];
#define CMB_COMPUTE(rr, X, Y, GG, GK) do { \
            const int r = (rr), s = r - (r / SB) * SB; \
            const LAS f32x4* mrow = mv + ((LAYER == 0 && s < CTXL) ? 768 : 0) + F.lane; \
            f32x4 v[4]; \
            _Pragma("unroll") for (int j = 0; j < 4; ++j) { \
                f32x4 a = {0.f, 0.f, 0.f, 0.f}; \
                _Pragma("unroll") for (int k = 0; k < 4; ++k) { const unsigned w = Y[k][j]; a.x += GK[k] * __builtin_amdgcn_cvt_f32_fp8(w, 0); a.y += GK[k] * __builtin_amdgcn_cvt_f32_fp8(w, 1); a.z += GK[k] * __builtin_amdgcn_cvt_f32_fp8(w, 2); a.w += GK[k] * __builtin_amdgcn_cvt_f32_fp8(w, 3); } \
                const f32x4 g = mrow[64 * j]; v[j] = x_wide(X[j]) + g * a; \
                if (LAYER == 1) { v[j].x += __builtin_amdgcn_cvt_f32_fp8(GG[j], 0); v[j].y += __builtin_amdgcn_cvt_f32_fp8(GG[j], 1); v[j].z += __builtin_amdgcn_cvt_f32_fp8(GG[j], 2); v[j].w += __builtin_amdgcn_cvt_f32_fp8(GG[j], 3); } } \
            if (LAYER == 1) { \
                f32x4* dst = (f32x4*)(F.out + ((size_t)(r / SB) * LSEQ + (s - CTXL)) * DM) + F.lane; \
                _Pragma("unroll") for (int j = 0; j < 4; ++j) __builtin_nontemporal_store(v[j], dst + 64 * j); \
            } else { \
                if (s >= CTXL) { u32x2* dst = (u32x2*)((bf16*)(F.ws + WS_XS2) + (size_t)r * DM) + F.lane; \
                    _Pragma("unroll") for (int j = 0; j < 4; ++j) __builtin_nontemporal_store((u32x2){pkbf(v[j].x, v[j].y), pkbf(v[j].z, v[j].w)}, dst + 64 * j); } \
                float ss = 0.f; \
                _Pragma("unroll") for (int j = 0; j < 4; ++j) ss += (v[j].x * v[j].x + v[j].y * v[j].y) + (v[j].z * v[j].z + v[j].w * v[j].w); \
                const float rstd = rsqrtf(wave_sum(ss) * (1.f / DM) + NORM_EPS); \
                unsigned* dst = (unsigned*)(F.ws + WS_HB + (size_t)r * DM) + F.lane;     \
                _Pragma("unroll") for (int j = 0; j < 4; ++j) { const f32x4 g = mrow[256 + 64 * j] * rstd, h = mrow[512 + 64 * j]; \
                    dst[64 * j] = pk4_fp8(v[j].x * g.x + h.x, v[j].y * g.y + h.y, v[j].z * g.z + h.z, v[j].w * g.w + h.w); } \
            } } while (0)
        CMB_RK(F.wave, rk, gkA); CMB_LOAD(CMB_ROW(nbase), rk, xa, ya, ga);
#pragma unroll 1
        for (int i = 0; i + 2 < NSTEP; i += 2) {
            const int n = nbase + 8 * i, li = F.wave + 8 * i;
            CMB_RK(li + 8, rk, gkB); CMB_LOAD(CMB_ROW(n + 8), rk, xb, yb, gb);
            __builtin_amdgcn_sched_barrier(0);
            CMB_COMPUTE(CMB_ROW(n), xa, ya, ga, gkA);
            __builtin_amdgcn_sched_barrier(0);
            CMB_RK(li + 16, rk, gkA); CMB_LOAD(CMB_ROW(n + 16), rk, xa, ya, ga);
            __builtin_amdgcn_sched_barrier(0);
            CMB_COMPUTE(CMB_ROW(n + 8), xb, yb, gb, gkB);
            __builtin_amdgcn_sched_barrier(0);
        }
        {   const int n = nbase + 8 * (NSTEP - 2), li = F.wave + 8 * (NSTEP - 2);
            CMB_RK(li + 8, rk, gkB); CMB_LOAD(CMB_ROW(n + 8), rk, xb, yb, gb);
            __builtin_amdgcn_sched_barrier(0);
            CMB_COMPUTE(CMB_ROW(n), xa, ya, ga, gkA);
            CMB_COMPUTE(CMB_ROW(n + 8), xb, yb, gb, gkB); }
#undef CMB_COMPUTE
    }
    __syncthreads();
#undef CMB_ROW
#undef CMB_RK
#undef CMB_LOAD
}

using g8::Unit;
#define ACC_T const f32x4 (&acc)[2][2][4][2]
#define DENSE_AOFF(LDA) __device__ __forceinline__ void aoff(const Unit&, int, const int (&R)[2], const int (&C)[2], unsigned (&o0)[2], unsigned (&o1)[2]) const { \
    _Pragma("unroll") for (int i = 0; i < 2; ++i) { o0[i] = (unsigned)(R[i] * (LDA) + C[i]) * 2u; o1[i] = o0[i] + 128u * (LDA) * 2u; } }
#define DENSE_AOFF8(LDAB) __device__ __forceinline__ void aoff(const Unit&, int, const int (&R)[2], const int (&C)[2], unsigned (&o0)[2], unsigned (&o1)[2]) const { \
    _Pragma("unroll") for (int i = 0; i < 2; ++i) { o0[i] = (unsigned)(R[i] * (LDAB) + C[i] * 2); o1[i] = o0[i] + 128u * (LDAB); } }
#define NO_VEC __device__ __forceinline__ void vec_issue(const Unit&, int, int) const {}
__device__ __forceinline__ void glds16(const void* g, ldsp l) { __builtin_amdgcn_global_load_lds((const unsigned*)g, (LAS unsigned*)l, 16, 0, 0); }
template <int NT> __device__ __forceinline__ void moe_deal(int i, int G, int c, int& mt, int& pn) {
    constexpr int MT = 32 / NT;
    if (G == 256) { const int x = c & 7, j = c >> 3; mt = (i * 8 + x) * MT + j / NT; pn = j % NT; }
    else { const int L = i * G + c; mt = L / NT; pn = L % NT; }
}

struct PS5a {
    static constexpr bool GATHER = false, FP8 = false; static constexpr int EPI_VM = 32;
    int K, ldb, G, c; const char* bcat; const char* fmat; float* sbuf;
    __device__ __forceinline__ bool next(int i, Unit& u) const { const int L = i * G + c; if (L >= 576) return false; const int g = L / 9, pm = L - g * 9;
        u.A = bcat + ((size_t)g * 2304 + pm * 256) * 1024; u.B = fmat + (size_t)g * 256 * 256 * 2; u.pm = pm; u.pn = 0; u.e = g; u.cnt = 0; u.tb = 0; return true; }
    DENSE_AOFF(512) NO_VEC
    __device__ __forceinline__ void epi(ACC_T, const Unit& u, int, int wr, int wc, int fr, int fq) const {
        float* base = sbuf + ((size_t)u.e * 2304 + u.pm * 256 + wr * 64 + fr) * 256 + wc * 32 + 4 * fq;
#pragma unroll
        for (int ai = 0; ai < 2; ++ai)
#pragma unroll
            for (int m = 0; m < 4; ++m) { float* rowp = base + (size_t)(ai * 128 + m * 16) * 256;
#pragma unroll
                for (int bj = 0; bj < 2; ++bj)
#pragma unroll
                    for (int n = 0; n < 2; ++n) *(f32x4*)(rowp + bj * 128 + n * 16) = acc[ai][bj][m][n]; }
    }
};
struct PS5c {
    static constexpr bool GATHER = false, FP8 = false; static constexpr int EPI_VM = 16;
    int K, ldb, G, c; const char* bcat; const char* acat; unsigned char* yact;
    __device__ __forceinline__ bool next(int i, Unit& u) const { const int L = i * G + c; if (L >= 576) return false; const int g = L / 9, pm = L - g * 9;
        u.A = bcat + ((size_t)g * 2304 + pm * 256) * 1024; u.B = acat + (size_t)g * 256 * 512 * 2; u.pm = pm; u.pn = 0; u.e = g; u.cnt = 0; u.tb = 0; return true; }
    DENSE_AOFF(512) NO_VEC
    __device__ __forceinline__ void epi(ACC_T, const Unit& u, int, int wr, int wc, int fr, int fq) const {
#pragma unroll
        for (int ai = 0; ai < 2; ++ai)
#pragma unroll
            for (int m = 0; m < 4; ++m) { const int col = u.pm * 256 + ai * 128 + wr * 64 + m * 16 + fr, b = col / NCHUNK, ch = col - b * NCHUNK;
#pragma unroll
                for (int bj = 0; bj < 2; ++bj) { const int jt = 8 * bj + 2 * wc + (fq >> 1);
                    const f32x4 v0 = acc[ai][bj][m][0], v1 = acc[ai][bj][m][1];
                    *(u32x2*)(yact + ((size_t)b * SB + ch * 16 + jt) * DM + u.e * 16 + 8 * (fq & 1)) =
                        (u32x2){pk4_fp8(gelu_tanh(v0.x), gelu_tanh(v0.y), gelu_tanh(v0.z), gelu_tanh(v0.w)), pk4_fp8(gelu_tanh(v1.x), gelu_tanh(v1.y), gelu_tanh(v1.z), gelu_tanh(v1.w))}; } }
    }
};
struct PGlu {
    static constexpr bool GATHER = false, FP8 = true; static constexpr int EPI_VM = 8;
    __device__ __forceinline__ void* probe_sink() const { return (void*)(F->ws + WS_CTL + 512 * 1024); }
    int K, ldb, G, c; const char* A; const char* B; const Ctx* F;
    __device__ __forceinline__ bool next(int i, Unit& u) const { int pm, pn; if (!g8::static_order(i, G, c, 144, 8, pm, pn)) return false;
        u.A = A + (size_t)pm * 256 * 1024; u.B = B + (size_t)pn * 256 * 1024; u.pm = pm; u.pn = pn; u.e = 0; u.cnt = 0; u.tb = 0; return true; }
    DENSE_AOFF8(1024)
    __device__ __forceinline__ void vec_issue(const Unit& u, int slot, int lane) const {
        const int b = u.pm / 9; const bool isctx = (u.pm - b * 9) == 0; const ldsp dst = F->lds + MISC_OFF + MO_VEC + slot * 2048;
        glds16(F->in[I_BGLU] + (lane >> 5) * 1024 + u.pn * 128 + 4 * (lane & 31), dst);
        glds16(modp(*F, 0, isctx ? 16 : b) + 2048 + u.pn * 128 + 4 * (lane & 31), dst + 1024);
    }
    __device__ __forceinline__ void epi(ACC_T, const Unit& u, int slot, int wr, int wc, int fr, int fq) const {
        const LAS float* vec = (const LAS float*)(F->lds + MISC_OFF + MO_VEC + slot * 2048); const int cl = wc * 32 + 8 * fq;
        f32x4 ba[2], bg[2], gt[2];
#pragma unroll
        for (int n = 0; n < 2; ++n) { ba[n] = *(const LAS f32x4*)(vec + cl + 4 * n); bg[n] = *(const LAS f32x4*)(vec + 128 + cl + 4 * n); gt[n] = *(const LAS f32x4*)(vec + 256 + cl + 4 * n); }
        unsigned char* yg = F->ws + WS_YG0;
#pragma unroll
        for (int ai = 0; ai < 2; ++ai)
#pragma unroll
            for (int m = 0; m < 4; ++m) { const int r = u.pm * 256 + ai * 128 + wr * 64 + m * 16 + fr;
                float o[8];
#pragma unroll
                for (int n = 0; n < 2; ++n) { const f32x4 a = acc[ai][0][m][n] * W8_INV + ba[n], g = acc[ai][1][m][n] * W8_INV + bg[n];
#pragma unroll
                    for (int j = 0; j < 4; ++j) o[4 * n + j] = gt[n][j] * a[j] * fast_sigmoid(g[j]); }
                *(u32x2*)(yg + (size_t)r * DM + u.pn * 128 + cl) = (u32x2){pk4_fp8(o[0], o[1], o[2], o[3]), pk4_fp8(o[4], o[5], o[6], o[7])}; }
    }
};
struct PMoeGu {
    static constexpr bool GATHER = true, FP8 = true; static constexpr int EPI_VM = 8;
    int K, ldb, G, c, layer; const Ctx* F; int ntiles;
    __device__ __forceinline__ bool next(int i, Unit& u) const { int mt, pn; moe_deal<8>(i, G, c, mt, pn); if (mt >= ntiles) return false;
        u32x2 rec = ((const LAS u32x2*)(F->lds + MISC_OFF + MO_SEL))[mt];
        rec.x = (unsigned)__builtin_amdgcn_readfirstlane((int)rec.x); rec.y = (unsigned)__builtin_amdgcn_readfirstlane((int)rec.y); const int e = (int)(rec.x & 255u);
        u.A = (const char*)(F->ws + WS_HB); u.B = (const char*)(F->ws + WS_WGU) + ((size_t)(layer * 32 + e) * 2048 + pn * 256) * 1024;
        u.pm = mt; u.pn = pn; u.e = e; u.cnt = (int)rec.y; u.tb = (int)(rec.x >> 8) * 256; return true; }
    __device__ __forceinline__ void tok_issue(const Unit& u, int slot, int lane) const {
        glds16((const int*)(F->ws + WS_TOKL) + (size_t)u.e * NROW + u.tb + 4 * lane, F->lds + MISC_OFF + MO_TOK + slot * 1024); }
    __device__ __forceinline__ void aoff(const Unit& u, int slot, const int (&R)[2], const int (&C)[2], unsigned (&o0)[2], unsigned (&o1)[2]) const {
        const LAS int* tl = (const LAS int*)(F->lds + MISC_OFF + MO_TOK + slot * 1024);
#pragma unroll
        for (int i = 0; i < 2; ++i) { const int t0 = R[i] < u.cnt ? tl[R[i]] : 0, t1 = (R[i] + 128) < u.cnt ? tl[R[i] + 128] : 0;
            o0[i] = (unsigned)(t0 * 1024 + C[i] * 2); o1[i] = (unsigned)(t1 * 1024 + C[i] * 2); }
    }
    __device__ __forceinline__ void vec_issue(const Unit& u, int slot, int lane) const {
        glds16(F->in[I_BGU] + (size_t)(layer * 32 + u.e) * 2048 + (lane >> 5) * 1024 + u.pn * 128 + 4 * (lane & 31), F->lds + MISC_OFF + MO_VEC + slot * 2048); }
    __device__ __forceinline__ void epi(ACC_T, const Unit& u, int slot, int wr, int wc, int fr, int fq) const {
        const LAS float* vec = (const LAS float*)(F->lds + MISC_OFF + MO_VEC + slot * 2048); const int cl = wc * 32 + 8 * fq;
        const f32x4 bg0 = *(const LAS f32x4*)(vec + cl), bg1 = *(const LAS f32x4*)(vec + cl + 4);
        const f32x4 bu0 = *(const LAS f32x4*)(vec + 128 + cl) + 1.0f, bu1 = *(const LAS f32x4*)(vec + 128 + cl + 4) + 1.0f;
        unsigned char* act = F->ws + WS_ACT;
#pragma unroll
        for (int ai = 0; ai < 2; ++ai)
#pragma unroll
            for (int m = 0; m < 4; ++m) { const int row = u.pm * 256 + ai * 128 + wr * 64 + m * 16 + fr;
                unsigned w2[2];
#pragma unroll
                for (int n = 0; n < 2; ++n) {
                    f32x4 gt = acc[ai][0][m][n] * W8_INV + (n ? bg1 : bg0), up = acc[ai][1][m][n] * W8_INV + (n ? bu1 : bu0);
                    gt = __builtin_elementwise_min(gt, (f32x4){7.f, 7.f, 7.f, 7.f});
                    up = __builtin_elementwise_min(__builtin_elementwise_max(up, (f32x4){-6.f, -6.f, -6.f, -6.f}), (f32x4){8.f, 8.f, 8.f, 8.f});
                    f32x4 e = gt * -2.45546696f;
                    e.x = __builtin_amdgcn_exp2f(e.x); e.y = __builtin_amdgcn_exp2f(e.y); e.z = __builtin_amdgcn_exp2f(e.z); e.w = __builtin_amdgcn_exp2f(e.w);
                    e = e + 1.0f;
                    e.x = __builtin_amdgcn_rcpf(e.x); e.y = __builtin_amdgcn_rcpf(e.y); e.z = __builtin_amdgcn_rcpf(e.z); e.w = __builtin_amdgcn_rcpf(e.w);
                    const f32x4 o = (up * gt) * e;
                    w2[n] = pk4_fp8(o.x, o.y, o.z, o.w); }
                *(u32x2*)(act + (size_t)row * DM + u.pn * 128 + cl) = (u32x2){w2[0], w2[1]}; }
    }
};
struct PMoeDn {
    static constexpr bool GATHER = false, FP8 = true; static constexpr int EPI_VM = 16;
    int K, ldb, G, c, layer; const Ctx* F; int ntiles;
    __device__ __forceinline__ bool next(int i, Unit& u) const { int mt, pn; moe_deal<4>(i, G, c, mt, pn); if (mt >= ntiles) return false;
        const int e = __builtin_amdgcn_readfirstlane((int)(((const LAS u32x2*)(F->lds + MISC_OFF + MO_SEL))[mt].x & 255u));
        u.A = (const char*)(F->ws + WS_ACT) + (size_t)mt * 256 * 1024; u.B = (const char*)(F->ws + WS_WDN) + ((size_t)(layer * 32 + e) * 1024 + pn * 256) * 1024;
        u.pm = mt; u.pn = pn; u.e = e; u.cnt = 0; u.tb = 0; return true; }
    __device__ __forceinline__ void aoff(const Unit&, int, const int (&R)[2], const int (&C)[2], unsigned (&o0)[2], unsigned (&o1)[2]) const {
#pragma unroll
        for (int i = 0; i < 2; ++i) { o0[i] = (unsigned)(R[i] * 1024 + C[i] * 2); o1[i] = o0[i] + 128u * 1024u; } }
    __device__ __forceinline__ void vec_issue(const Unit& u, int slot, int lane) const {
        glds16(F->in[I_BDN] + (size_t)(layer * 32 + u.e) * 1024 + u.pn * 256 + 4 * lane, F->lds + MISC_OFF + MO_VEC + slot * 2048); }
    __device__ __forceinline__ void epi(ACC_T, const Unit& u, int slot, int wr, int wc, int fr, int fq) const {
        const LAS float* vec = (const LAS float*)(F->lds + MISC_OFF + MO_VEC + slot * 2048); unsigned char* ys = F->ws + WS_YS;
#pragma unroll
        for (int bj = 0; bj < 2; ++bj) { const int cl = bj * 128 + wc * 32 + 8 * fq; const f32x4 b0 = *(const LAS f32x4*)(vec + cl), b1 = *(const LAS f32x4*)(vec + cl + 4);
#pragma unroll
            for (int ai = 0; ai < 2; ++ai)
#pragma unroll
                for (int m = 0; m < 4; ++m) { const int row = u.pm * 256 + ai * 128 + wr * 64 + m * 16 + fr; const f32x4 v0 = acc[ai][bj][m][0] * W8_INV + b0, v1 = acc[ai][bj][m][1] * W8_INV + b1;
                    *(u32x2*)(ys + (size_t)row * DM + u.pn * 256 + cl) = (u32x2){pk4_fp8(v0.x, v0.y, v0.z, v0.w), pk4_fp8(v1.x, v1.y, v1.z, v1.w)}; } }
    }
};
struct PQkv {
    static constexpr bool GATHER = false, FP8 = true; static constexpr int EPI_VM = 16;
    int K, ldb, G, c; const char* H; const char* W; const Ctx* F; bf16* vt;
    __device__ __forceinline__ bool next(int i, Unit& u) const { long L = (long)i * G + c; int pm, pn;
        if (L < 576) { g8::static_order_l(L, 144, 4, pm, pn); pn += 4; u.e = 0; }
        else if (L < 1088) { g8::static_order_l(L - 576, 128, 4, pm, pn); pm = (pm >> 3) * 9 + 1 + (pm & 7); u.e = 0; }
        else if (L < 1664) { g8::static_order_l(L - 1088, 4, 144, pm, pn); u.e = 1; }
        else return false;
        if (u.e == 0) { u.A = H + (size_t)pm * 256 * 1024; u.B = W + (size_t)pn * 256 * 1024; } else { u.A = W + (size_t)(2048 + pm * 256) * 1024; u.B = H + (size_t)pn * 256 * 1024; }
        u.pm = pm; u.pn = pn; u.cnt = 0; u.tb = 0; return true; }
    DENSE_AOFF8(1024) NO_VEC
    __device__ __forceinline__ void epi(ACC_T, const Unit& u, int, int wr, int wc, int fr, int fq) const { if (u.e == 0) epi_qk(acc, u, wr, wc, fr, fq); else epi_vt(acc, u, wr, wc, fr, fq); }
    __device__ __forceinline__ void epi_qk(ACC_T, const Unit& u, int wr, int wc, int fr, int fq) const {
        const int b = u.pm / 9, t9 = u.pm - b * 9; const bool isctx = t9 == 0, isk = u.pn >= 4;
        if (!isk && isctx) return;
        const int hc = (u.pn & 3) * 4 + wc, h = hc >> 1, comp = hc & 1;
        const LAS float* gain = (const LAS float*)(F->lds + MISC_OFF + MO_GAIN) + (isk ? 64 : 0);
        const f32x4 g00 = *(const LAS f32x4*)(gain + 8 * fq), g01 = *(const LAS f32x4*)(gain + 8 * fq + 4), g10 = *(const LAS f32x4*)(gain + 32 + 8 * fq), g11 = *(const LAS f32x4*)(gain + 32 + 8 * fq + 4);
        const LAS f32x4* rope = (const LAS f32x4*)(F->lds + MISC_OFF + MO_SEL) + 4 * (fq & 1);
        const float oscale = isk ? 1.0f : 0.18033688011112042f;
        unsigned char* dstb = isk ? F->ws + WS_K + ((size_t)((b * 8 + h) * 2 + comp) * SB) * 64 : F->ws + WS_Q + ((size_t)((b * 8 + h) * 2 + comp) * LSEQ) * 64;
#pragma unroll
        for (int ai = 0; ai < 2; ++ai)
#pragma unroll
            for (int m = 0; m < 4; ++m) {
                const int s = t9 * 256 + ai * 128 + wr * 64 + m * 16 + fr;
                float ss = 0.f;
#pragma unroll
                for (int bj = 0; bj < 2; ++bj)
#pragma unroll
                    for (int n = 0; n < 2; ++n) { const f32x4 x = acc[ai][bj][m][n]; ss += (x.x * x.x + x.y * x.y) + (x.z * x.z + x.w * x.w); }
                ss += __shfl_xor(ss, 16); ss += __shfl_xor(ss, 32);
                const float rstd = rsqrtf(ss * (W8_INV * W8_INV / 64.0f) + NORM_EPS) * W8_INV;
                float v1[8], v2[8];
#pragma unroll
                for (int n = 0; n < 2; ++n)
#pragma unroll
                    for (int j = 0; j < 4; ++j) { v1[4 * n + j] = acc[ai][0][m][n][j] * rstd * (n ? g01[j] : g00[j]); v2[4 * n + j] = acc[ai][1][m][n][j] * rstd * (n ? g11[j] : g10[j]); }
                if (!isctx) {
                    const int pos = s - CTXL, pvi = (fq < 2) ? (pos >> 6) : (pos & 63);
#pragma unroll
                    for (int q2 = 0; q2 < 4; ++q2) { const f32x4 t = rope[pvi * 8 + q2];
                        { const float a = v1[2 * q2], bb2 = v2[2 * q2]; v1[2 * q2] = a * t.x - bb2 * t.y; v2[2 * q2] = bb2 * t.x + a * t.y; }
                        { const float a = v1[2 * q2 + 1], bb2 = v2[2 * q2 + 1]; v1[2 * q2 + 1] = a * t.z - bb2 * t.w; v2[2 * q2 + 1] = bb2 * t.z + a * t.w; } }
                }
                unsigned char* dst = dstb + (size_t)(isk ? s : s - CTXL) * 64 + 8 * fq;
                *(u32x2*)dst = (u32x2){pk4_fp8(v1[0] * oscale, v1[1] * oscale, v1[2] * oscale, v1[3] * oscale), pk4_fp8(v1[4] * oscale, v1[5] * oscale, v1[6] * oscale, v1[7] * oscale)};
                *(u32x2*)(dst + 32) = (u32x2){pk4_fp8(v2[0] * oscale, v2[1] * oscale, v2[2] * oscale, v2[3] * oscale), pk4_fp8(v2[4] * oscale, v2[5] * oscale, v2[6] * oscale, v2[7] * oscale)};
            }
    }
    __device__ __forceinline__ void epi_vt(ACC_T, const Unit& u, int wr, int wc, int fr, int fq) const {
        const int b = u.pn / 9, tcol = (u.pn - b * 9) * 256; unsigned char* vt8 = (unsigned char*)vt;
#pragma unroll
        for (int ai = 0; ai < 2; ++ai)
#pragma unroll
            for (int m = 0; m < 4; ++m) { const int mrow = u.pm * 256 + ai * 128 + wr * 64 + m * 16 + fr; unsigned char* rowp = vt8 + ((size_t)b * 1024 + mrow) * SB + tcol + 64 * (wc >> 1) + 16 * (wc & 1) + 32 * (fq & 1) + 4 * (fq >> 1);
#pragma unroll
                for (int bj = 0; bj < 2; ++bj)
#pragma unroll
                    for (int n = 0; n < 2; ++n) { const f32x4 v = acc[ai][bj][m][n] * W8_INV; *(unsigned*)(rowp + 128 * bj + 8 * n) = pk4_fp8(v.x, v.y, v.z, v.w); } }
    }
};
struct POut {
    static constexpr bool GATHER = false, FP8 = true; static constexpr int EPI_VM = 16;
    int K, ldb, G, c; const char* A; const char* B; const Ctx* F;
    __device__ __forceinline__ bool next(int i, Unit& u) const { int pm, pn; if (!g8::static_order(i, G, c, 128, 4, pm, pn)) return false;
        u.A = A + (size_t)pm * 256 * 1024; u.B = B + (size_t)pn * 256 * 1024; u.pm = pm; u.pn = pn; u.e = 0; u.cnt = 0; u.tb = 0; return true; }
    DENSE_AOFF8(1024)
    __device__ __forceinline__ void vec_issue(const Unit& u, int slot, int lane) const { glds16(modp(*F, 1, u.pm >> 3) + 2048 + u.pn * 256 + 4 * lane, F->lds + MISC_OFF + MO_VEC + slot * 2048); }
    __device__ __forceinline__ void epi(ACC_T, const Unit& u, int slot, int wr, int wc, int fr, int fq) const {
        const LAS float* vec = (const LAS float*)(F->lds + MISC_OFF + MO_VEC + slot * 2048); const int b = u.pm >> 3; unsigned char* yg = F->ws + WS_YG1;
#pragma unroll
        for (int bj = 0; bj < 2; ++bj) { const int cl = bj * 128 + wc * 32 + 8 * fq; const f32x4 g0 = *(const LAS f32x4*)(vec + cl), g1 = *(const LAS f32x4*)(vec + cl + 4);
#pragma unroll
            for (int ai = 0; ai < 2; ++ai)
#pragma unroll
                for (int m = 0; m < 4; ++m) { const int nl = u.pm * 256 + ai * 128 + wr * 64 + m * 16 + fr; const size_t r = (size_t)b * SB + CTXL + (nl & 2047);
                    const f32x4 v0 = acc[ai][bj][m][0] * (g0 * W8_INV), v1 = acc[ai][bj][m][1] * (g1 * W8_INV);
                    *(u32x2*)(yg + r * DM + u.pn * 256 + cl) = (u32x2){pk4_fp8(v0.x, v0.y, v0.z, v0.w), pk4_fp8(v1.x, v1.y, v1.z, v1.w)}; } }
    }
};

__device__ __forceinline__ void attn_stage(const Ctx& F, const char* ubase, unsigned ustep, const unsigned (&off)[4], int buf) {
#pragma unroll
    for (int ii = 0; ii < 8; ++ii)
        __builtin_amdgcn_global_load_lds((const unsigned*)(ubase + (size_t)ii * ustep + off[ii & 3]), (LAS unsigned*)(F.lds + buf * 65536 + (F.wave * 8 + ii) * 1024), 16, 0, 0);
}
__device__ __forceinline__ void p_attn(const Ctx& F) {
    float lam;
    { const float a = F.in[I_LQ1][F.lane] * F.in[I_LK1][F.lane], b2 = F.in[I_LQ2][F.lane] * F.in[I_LK2][F.lane]; lam = __builtin_bit_cast(float, __builtin_amdgcn_readfirstlane(__builtin_bit_cast(int, __expf(wave_sum(a)) - __expf(wave_sum(b2)) + LAMBDA_INIT))); }
    const int r = F.lane & 31, hh = F.lane >> 5, fsw = (r >> 1) & 7, ksw = (r >> 2) & 3;
#define ATT_SOFF(soff) unsigned soff[4]; { int ln = F.lane; asm volatile("" : "+v"(ln)); \
        if (F.wave < 4) { const int row16 = ln >> 2, c0 = (ln & 3) ^ ((row16 >> 2) & 3); soff[0] = soff[1] = soff[2] = soff[3] = row16 * 64 + c0 * 16; }     \
        else { const int row4 = ln >> 4, pos = ln & 15; _Pragma("unroll") for (int q = 0; q < 4; ++q) soff[q] = (unsigned)row4 * SB + (unsigned)((pos ^ (4 * q + row4)) << 4); } }
    const int r15 = r & 15;
    const int vcu = (F.G % 8 == 0) ? (F.blk % 8) * (F.G / 8) + F.blk / 8 : F.blk;
    for (int un = vcu; un < NB * 8 * 8; un += F.G) {
        const int b = un >> 6, h = (un >> 3) & 7, qt = un & 7, q0 = qt * 256 + F.wave * 32;
        const unsigned char* Qb = F.ws + WS_Q + ((size_t)((b * 8 + h) * 2) * LSEQ) * 64;
        const unsigned char* Kb = F.ws + WS_K + ((size_t)((b * 8 + h) * 2) * SB) * 64;
        const unsigned char* Vb = (const unsigned char*)(F.ws + WS_VT) + ((size_t)(b * 8 + h) * 128) * SB;
        v8i qf8[2];
#pragma unroll
        for (int comp = 0; comp < 2; ++comp) { const unsigned char* qp = Qb + ((size_t)comp * LSEQ + q0 + r) * 64 + 32 * hh;
            qf8[comp] = __builtin_shufflevector(*(const v4i*)qp, *(const v4i*)(qp + 16), 0, 1, 2, 3, 4, 5, 6, 7); }
        f32x16 o1[4], o2[4];
#pragma unroll
        for (int d = 0; d < 4; ++d)
#pragma unroll
            for (int i = 0; i < 16; ++i) { o1[d][i] = 0.f; o2[d][i] = 0.f; }
        v8i onesA; { const int m = F.lane & 15, kg = F.lane >> 4; const int w = ((m == 0 && !(kg & 1)) || (m == 1 && (kg & 1))) ? 0x38383838 : 0;
#pragma unroll
            for (int i = 0; i < 8; ++i) onesA[i] = w; }
        f32x4 ls1 = {0.f, 0.f, 0.f, 0.f}, ls2 = {0.f, 0.f, 0.f, 0.f};
        const char* sbase = F.wave < 4 ? (const char*)Kb + (size_t)(F.wave >> 1) * SB * 64 + (F.wave & 1) * 8192 : (const char*)Vb + (size_t)(32 * (F.wave - 4)) * SB;
        const unsigned kadv = F.wave < 4 ? 256u * 64u : 256u, sstep = F.wave < 4 ? 1024u : 4u * SB;
        const bool stager = true;
        v8i pf1, pf2;
#define ATT_SOFT(base, kb, HALF) do { f32x16 s1, s2, z16; \
            _Pragma("unroll") for (int i = 0; i < 16; ++i) z16[i] = 0.f; \
            const int kro = (32 * (kb) + r) * 64, kc0 = ((2 * hh) ^ ksw) << 4, kc1 = ((2 * hh + 1) ^ ksw) << 4; \
            const v8i kfa = __builtin_shufflevector(*(const LAS v4i*)((base) + kro + kc0), *(const LAS v4i*)((base) + kro + kc1), 0, 1, 2, 3, 4, 5, 6, 7); \
            const v8i kfb = __builtin_shufflevector(*(const LAS v4i*)((base) + 16384 + kro + kc0), *(const LAS v4i*)((base) + 16384 + kro + kc1), 0, 1, 2, 3, 4, 5, 6, 7); \
            __builtin_amdgcn_sched_barrier(0); \
            s1 = __builtin_amdgcn_mfma_scale_f32_32x32x64_f8f6f4(kfa, qf8[0], z16, 0, 0, 0, 0, 0, 0);     \
            s2 = __builtin_amdgcn_mfma_scale_f32_32x32x64_f8f6f4(kfb, qf8[1], z16, 0, 0, 0, 0, 0, 0); \
            asm volatile("" : "+v"(s1), "+v"(s2));     \
            __builtin_amdgcn_sched_barrier(0); \
            _Pragma("unroll") for (int i = 0; i < 16; ++i) { s1[i] = __builtin_amdgcn_exp2f(s1[i]); } \
            _Pragma("unroll") for (int q4 = 0; q4 < 4; ++q4) pf1[4 * (HALF) + q4] = pk4_fp8_d16(s1[4 * q4], s1[4 * q4 + 1], s1[4 * q4 + 2], s1[4 * q4 + 3]); \
            _Pragma("unroll") for (int i = 0; i < 16; ++i) { s2[i] = __builtin_amdgcn_exp2f(s2[i]); } \
            _Pragma("unroll") for (int q4 = 0; q4 < 4; ++q4) pf2[4 * (HALF) + q4] = pk4_fp8_d16(s2[4 * q4], s2[4 * q4 + 1], s2[4 * q4 + 2], s2[4 * q4 + 3]); \
            __builtin_amdgcn_sched_barrier(0); } while (0)
#define ATT_PV(base, b64) do { v8i vf[4]; \
            _Pragma("unroll") for (int dvb = 0; dvb < 4; ++dvb) { const int ro = 32768 + (32 * dvb + r) * 256; \
                const v4i lo = *(const LAS v4i*)((base) + ro + (((4 * (b64) + 2 * hh) ^ r15) << 4)), hi = *(const LAS v4i*)((base) + ro + (((4 * (b64) + 2 * hh + 1) ^ r15) << 4)); \
                vf[dvb] = __builtin_shufflevector(lo, hi, 0, 1, 2, 3, 4, 5, 6, 7); } \
            __builtin_amdgcn_sched_barrier(0); \
            _Pragma("unroll") for (int dvb = 0; dvb < 4; ++dvb) { \
                asm volatile("v_mfma_f32_32x32x64_f8f6f4 %0, %1, %2, %0" : "+v"(o1[dvb]) : "v"(vf[dvb]), "v"(pf1)); \
                asm volatile("v_mfma_f32_32x32x64_f8f6f4 %0, %1, %2, %0" : "+v"(o2[dvb]) : "v"(vf[dvb]), "v"(pf2)); } \
            asm volatile("v_mfma_f32_16x16x128_f8f6f4 %0, %1, %2, %0" : "+v"(ls1) : "v"(onesA), "v"(pf1)); \
            asm volatile("v_mfma_f32_16x16x128_f8f6f4 %0, %1, %2, %0" : "+v"(ls2) : "v"(onesA), "v"(pf2)); \
            __builtin_amdgcn_sched_barrier(0); } while (0)
#define ATT_XC(flag, waitasm) asm volatile("s_cmp_eq_u32 %0, 0\n\ts_cbranch_scc1 .Lax%=\n\t" waitasm "\n\ts_barrier\n.Lax%=:" :: "s"(__builtin_amdgcn_readfirstlane((int)(flag))) : "memory", "scc")
#define ATT_XCP(flag, waitasm) asm volatile("s_cmp_eq_u32 %2, 0\n\ts_cbranch_scc1 .Lax%=\n\t" waitasm "\n\ts_barrier\n.Lax%=:" : "+v"(pf1), "+v"(pf2) : "s"(__builtin_amdgcn_readfirstlane((int)(flag))) : "memory", "scc")
#define ATT_XCO(flag, waitasm) asm volatile("s_cmp_eq_u32 %8, 0\n\ts_cbranch_scc1 .Lax%=\n\t" waitasm "\n\ts_barrier\n.Lax%=:" : "+v"(o1[0]), "+v"(o1[1]), "+v"(o1[2]), "+v"(o1[3]), "+v"(o2[0]), "+v"(o2[1]), "+v"(o2[2]), "+v"(o2[3]) : "s"(__builtin_amdgcn_readfirstlane((int)(flag))) : "memory", "scc")
        constexpr int NT = SB / 256;
        const int grpA = F.wave < 4 ? 1 : 0;
        if (stager) { ATT_SOFF(soff) attn_stage(F, sbase, sstep, soff, 0); }
        ATT_XC(1 - grpA, "s_waitcnt vmcnt(0)"); ATT_XC(1 - grpA, "s_nop 0");
#pragma unroll 1
        for (int kt = 0; kt < NT; ++kt) {
            const int buf = kt & 1; const ldsp base = F.lds + buf * 65536;
            const int flagB = (1 - grpA) & (kt + 1 < NT ? 1 : 0);
            ATT_XCO(grpA, "s_waitcnt vmcnt(0)");
            ATT_SOFT(base, 0, 0);
            ATT_XCP(grpA, "s_waitcnt lgkmcnt(0)");
            if (kt + 1 < NT && stager) { ATT_SOFF(soff) attn_stage(F, sbase + (size_t)(kt + 1) * kadv, sstep, soff, buf ^ 1); }
            ATT_SOFT(base, 1, 1); ATT_PV(base, 0); ATT_SOFT(base, 2, 0); ATT_SOFT(base, 3, 1); ATT_PV(base, 1);
            ATT_SOFT(base, 4, 0); ATT_SOFT(base, 5, 1); ATT_PV(base, 2); ATT_SOFT(base, 6, 0); ATT_SOFT(base, 7, 1);
            ATT_XCP(flagB, "s_waitcnt vmcnt(0)");
            ATT_PV(base, 3);
            ATT_XCO(flagB, "s_waitcnt lgkmcnt(0)");
        }
#undef ATT_XC
#undef ATT_XCP
#undef ATT_XCO
#undef ATT_SOFT
#undef ATT_PV
        float l1, l2;
        { const float a0 = __shfl(ls1[0], r & 15), a1 = __shfl(ls1[1], r & 15), b0 = __shfl(ls2[0], r & 15), b1 = __shfl(ls2[1], r & 15); l1 = (r & 16) ? a1 : a0; l2 = (r & 16) ? b1 : b0; }
        const float i1 = 1.0f / l1, i2 = lam / l2;
        float ss = 0.f;
#pragma unroll
        for (int d = 0; d < 4; ++d)
#pragma unroll
            for (int i = 0; i < 16; ++i) { const float v = o1[d][i] * i1 - o2[d][i] * i2; o1[d][i] = v; ss += v * v; }
        ss += __shfl_xor(ss, 32);
        const float rstd = rsqrtf(ss * (1.0f / 128.0f) + NORM_EPS) * (1.0f - LAMBDA_INIT);
        unsigned char* orow = F.ws + WS_OATT + ((size_t)b * LSEQ + q0 + r) * DM + h * 128;
#pragma unroll
        for (int d = 0; d < 4; ++d)
#pragma unroll
            for (int g4 = 0; g4 < 4; ++g4) { const int dv = 32 * d + 8 * g4 + 4 * hh; const f32x4 sg = *(const f32x4*)(F.in[I_SUBG] + dv);
                *(unsigned*)(orow + dv) = pk4_fp8(o1[d][4 * g4] * rstd * sg.x, o1[d][4 * g4 + 1] * rstd * sg.y, o1[d][4 * g4 + 2] * rstd * sg.z, o1[d][4 * g4 + 3] * rstd * sg.w); }
    }
}

__global__ void __launch_bounds__(512, 2) mk_fwd(Args args) {
    extern __shared__ __attribute__((aligned(16))) unsigned char lds_raw[];
    Ctx F; F.in = args.in; F.out = args.out; F.ws = args.ws; F.lds = (ldsp)lds_raw;
    F.tid = threadIdx.x; F.lane = F.tid & 63; F.wave = __builtin_amdgcn_readfirstlane(F.tid >> 6); F.blk = blockIdx.x; F.G = gridDim.x;
    volatile LAS unsigned* misc = (volatile LAS unsigned*)(F.lds + MISC_OFF);
    if (F.tid < 8) misc[F.tid] = 0u;
    __syncthreads();
    unsigned* ctl = (unsigned*)(F.ws + WS_CTL);
    XcdBarrier bar; bar.bar = ctl + CW_BAR; bar.x = 0; bar.st = misc; bar.total = gridDim.x; bar.w = (unsigned)F.wave;
    const int lo = args.ph_lo, hi = args.ph_hi;
    if (hi - lo > 1) bar = xcd_barrier_post(ctl + CW_BAR, misc, gridDim.x, (unsigned)F.wave);
#ifndef PH_MASK
#define PH_MASK 0xFFFFFFFFu
#endif
#define IN(k) (((PH_MASK >> (k)) & 1u) && lo <= (k) && (k) < hi)
#define SEAM(k) do { if (IN(k) && IN((k) + 1)) xcd_barrier(bar); } while (0)
    const LAS int* pref = (const LAS int*)(F.lds + MISC_OFF + MO_PREF); const LAS int* cnt = (const LAS int*)(F.lds + MISC_OFF + MO_CNT);
    const char* ws = (const char*)F.ws;

#ifndef DUP_MASK
#define DUP_MASK 0u
#endif
#define FRESH() do { F.lane = fresh_lane(); F.tid = F.wave * 64 + F.lane; } while (0)
#define RUNPH(k, ...) do { if (IN(k)) { FRESH(); __VA_ARGS__ if ((DUP_MASK >> (k)) & 1u) { xcd_barrier(bar); FRESH(); __VA_ARGS__ } } SEAM(k); } while (0)
#if MK_ONE_LAUNCH
    if (lo == 0 && hi == NPHASE && F.G == 256) {
        FRESH(); p0_prep(F); xcd_barrier(bar);
        const int nA = SPLIT_A * 8, nB = F.G - nA;
        if (F.blk < nA) {
            XcdBarrier barA = xcd_barrier_post(ctl + CW_BAR2, misc + 4, (unsigned)nA, (unsigned)F.wave);
            FRESH(); Ctx FA = F; FA.G = nA;
            p1_norm0(FA); xcd_barrier(barA);
            { PS5a P{256, 256, FA.G, FA.blk, ws + WS_BCAT, ws + WS_FMAT, (float*)(F.ws + WS_SBUF)}; g8::gemm_phase(F.lds, P, F.wave); } xcd_barrier(barA);
            FRESH(); FA.lane = F.lane; FA.tid = F.tid; p3_carry(FA); xcd_barrier(barA);
            { PS5c P{512, 512, FA.G, FA.blk, ws + WS_BCAT, ws + WS_ACAT, F.ws + WS_HB}; g8::gemm_phase(F.lds, P, F.wave); }
        } else { FRESH(); p0_moe_weights(F, F.blk - nA, nB); }
        xcd_barrier(bar);
    } else
#endif
    {
    RUNPH(0, { p0_prep(F); p0_moe_weights(F, F.blk, F.G); });
    RUNPH(1, { p1_norm0(F); });
    RUNPH(2, { PS5a P{256, 256, F.G, F.blk, ws + WS_BCAT, ws + WS_FMAT, (float*)(F.ws + WS_SBUF)}; g8::gemm_phase(F.lds, P, F.wave); });
    RUNPH(3, { p3_carry(F); });
    RUNPH(4, { PS5c P{512, 512, F.G, F.blk, ws + WS_BCAT, ws + WS_ACAT, F.ws + WS_HB}; g8::gemm_phase(F.lds, P, F.wave); });
    }
    RUNPH(5, { PGlu P{1024, 1024, F.G, F.blk, ws + WS_HB, ws + WS_WGLU, &F}; g8::gemm_phase(F.lds, P, F.wave); });
#ifdef GEMM_PROBE
    if (IN(5)) { PGlu P{1024, 1024, F.G, F.blk, ws + WS_HB, ws + WS_WGLU, &F}; g8::gemm_phase<PGlu, GEMM_PROBE>(F.lds, P, F.wave); xcd_barrier(bar); }
#endif
    if (IN(6)) { FRESH(); p_router<0>(F); if ((DUP_MASK >> 6) & 1u) { xcd_barrier(bar); if (F.blk == 0 && F.tid < 32) __hip_atomic_store(ctl + CW_CNT + F.tid * 64, 0u, __ATOMIC_RELAXED, __HIP_MEMORY_SCOPE_AGENT); xcd_barrier(bar); p_router<0>(F); } } SEAM(6);
    RUNPH(7, { load_prefix(F, 0); PMoeGu P{1024, 1024, F.G, F.blk, 0, &F, pref[32]}; g8::gemm_phase(F.lds, P, F.wave); });
    RUNPH(8, { load_prefix(F, 0); PMoeDn P{1024, 1024, F.G, F.blk, 0, &F, pref[32]}; g8::gemm_phase(F.lds, P, F.wave); });
    RUNPH(9, { p_combine<0>(F); });
    RUNPH(10, { if (F.tid < 128) ((LAS float*)(F.lds + MISC_OFF + MO_GAIN))[F.tid] = F.tid < 64 ? F.in[I_QGAIN][F.tid] : F.in[I_KGAIN][F.tid - 64];
                for (int i = F.tid; i < 1024; i += 512) { const float ang = (float)(i >> 4) * __expf(-9.210340371976184f * (float)(i & 15) * (1.0f / 16.0f)); ((LAS f32x2*)(F.lds + MISC_OFF + MO_SEL))[i] = (f32x2){__cosf(ang), __sinf(ang)}; }
                __syncthreads();
                { PQkv P{1024, 1024, F.G, F.blk, ws + WS_HB, ws + WS_WQKV, &F, (bf16*)(F.ws + WS_VT)}; g8::gemm_phase(F.lds, P, F.wave); } });
    RUNPH(11, { p_attn(F); });
    RUNPH(12, { POut P{1024, 1024, F.G, F.blk, ws + WS_OATT, ws + WS_WO, &F}; g8::gemm_phase(F.lds, P, F.wave); });
    RUNPH(13, { p_router<1>(F); });
    RUNPH(14, { load_prefix(F, 1); PMoeGu P{1024, 1024, F.G, F.blk, 1, &F, pref[32]}; g8::gemm_phase(F.lds, P, F.wave); });
    RUNPH(15, { load_prefix(F, 1); PMoeDn P{1024, 1024, F.G, F.blk, 1, &F, pref[32]}; g8::gemm_phase(F.lds, P, F.wave); });
    if (IN(16)) { FRESH(); p_combine<1>(F); if ((DUP_MASK >> 16) & 1u) { xcd_barrier(bar); FRESH(); p_combine<1>(F); } }
#undef RUNPH
#undef IN
#undef SEAM
}

extern "C" void kernel_launch(void* const* d_in, const int* in_sizes, int n_in, void* d_out, int out_size, void* d_ws, size_t ws_size, hipStream_t stream) {
    static int grid = 0;
    if (grid == 0) {
        if (n_in != 33 || in_sizes[0] != NLAT * DM || out_size != NLAT * DM || ws_size < WS_END) { fprintf(stderr, "kernel_launch: unexpected problem (n_in %d, ws %zu); nothing launched\n", n_in, ws_size); grid = -1; return; }
        int dev = 0, cus = 0, per_cu = 0;
        if (hipGetDevice(&dev) != hipSuccess || hipDeviceGetAttribute(&cus, hipDeviceAttributeMultiprocessorCount, dev) != hipSuccess) { grid = -1; return; }
        if (hipFuncSetAttribute((const void*)mk_fwd, hipFuncAttributeMaxDynamicSharedMemorySize, LDS_BYTES) != hipSuccess) { fprintf(stderr, "kernel_launch: hipFuncSetAttribute failed\n"); grid = -1; return; }
        if (hipOccupancyMaxActiveBlocksPerMultiprocessor(&per_cu, (const void*)mk_fwd, 512, LDS_BYTES) != hipSuccess || per_cu < 1) fprintf(stderr, "kernel_launch: note: occupancy query reports %d\n", per_cu);
        (void)hipGetLastError();
        grid = cus;
    }
    if (grid < 0) return;
    if (hipMemsetAsync((char*)d_ws + WS_CTL, 0, CTL_ZERO_BYTES, stream) != hipSuccess) return;
    Args a{};
    for (int i = 0; i < 33; ++i) a.in[i] = (const float*)d_in[i];
    a.out = (float*)d_out; a.ws = (unsigned char*)d_ws;
#if MK_ONE_LAUNCH
    a.ph_lo = 0; a.ph_hi = NPHASE;
    hipLaunchKernelGGL(mk_fwd, dim3(grid), dim3(512), LDS_BYTES, stream, a);
#else
    for (int p = 0; p < NPHASE; ++p) { a.ph_lo = p; a.ph_hi = p + 1; hipLaunchKernelGGL(mk_fwd, dim3(grid), dim3(512), LDS_BYTES, stream, a); }
#endif
}
```
